# Optimizing an MI355X kernel written in HIP

```python
import math
import jax, jax.numpy as jnp
from jax import lax
import numpy as np

D_MODEL = 1024
BATCH = 2
SEQ = 8192
DEPTH = 2

N_MEM = 256
D_MIX = D_MODEL
D_DIFF = D_MIX // 2
N_DIFF_HEADS = 4
DIFF_V_DIM = D_DIFF // N_DIFF_HEADS
DIFF_QK_DIM = DIFF_V_DIM // 2
ROPE_DIM = DIFF_QK_DIM // 4
ROPE_THETA = 500000.0
D_GMLP = D_MIX - D_DIFF
N_GMLP_GROUPS = 4
GMLP_GROUP_DIM = D_GMLP // N_GMLP_GROUPS
CHUNK = 128
Q_BLOCK = 128
N_CROSS_HEADS = 4
CROSS_HEAD_DIM = D_MODEL // N_CROSS_HEADS
D_FF = ((8 * D_MODEL // 3 + 255) // 256) * 256
D_IN = 3 * D_DIFF + 2 * D_GMLP
NORM_EPS = 1e-6
NEG_INF = -1e30

kernel_name = 'hybrid_diffattn_gmlp_macaron'


def rms_norm(x, g):
    xf = x.astype(jnp.float32)
    y = xf * lax.rsqrt(jnp.mean(xf * xf, axis=-1, keepdims=True) + NORM_EPS)
    return (y * g.astype(jnp.float32)).astype(x.dtype)


def layer_norm(x, g, b):
    xf = x.astype(jnp.float32)
    mu = jnp.mean(xf, axis=-1, keepdims=True)
    xc = xf - mu
    y = xc * lax.rsqrt(jnp.mean(xc * xc, axis=-1, keepdims=True) + NORM_EPS)
    return (y * g.astype(jnp.float32) + b.astype(jnp.float32)).astype(x.dtype)


def swiglu(x, wgu, wd):
    gate, up = jnp.split(x @ wgu, 2, axis=-1)
    return (jax.nn.silu(gate) * up) @ wd


def rope_tables(positions):
    inv_freq = 1.0 / (ROPE_THETA ** (jnp.arange(0, ROPE_DIM, 2, dtype=jnp.float32) / ROPE_DIM))
    ang = positions.astype(jnp.float32)[..., None] * inv_freq
    return jnp.cos(ang), jnp.sin(ang)


def partial_rope(t, cos, sin):
    c = cos[:, :, None, None, :].astype(t.dtype)
    s = sin[:, :, None, None, :].astype(t.dtype)
    half = ROPE_DIM // 2
    t1 = t[..., :half]
    t2 = t[..., half:ROPE_DIM]
    return jnp.concatenate([t1 * c - t2 * s, t2 * c + t1 * s, t[..., ROPE_DIM:]], axis=-1)


def diff_attention(q, k, v, lam):
    b, s = q.shape[0], q.shape[1]
    nb = s // Q_BLOCK
    k1 = k[..., 0, :].transpose(0, 2, 1, 3)
    k2 = k[..., 1, :].transpose(0, 2, 1, 3)
    vh = v.transpose(0, 2, 1, 3)
    qb = (q * (DIFF_QK_DIM ** -0.5)).reshape(b, nb, Q_BLOCK, N_DIFF_HEADS, 2, DIFF_QK_DIM)
    qb = qb.transpose(1, 0, 3, 4, 2, 5)
    key_pos = jnp.arange(s)
    lam32 = lam.astype(jnp.float32)

    def one_block(args):
        qblk, start = args
        q_pos = start + jnp.arange(Q_BLOCK)
        causal = key_pos[None, :] <= q_pos[:, None]
        s1 = jnp.einsum('bhqd,bhkd->bhqk', qblk[:, :, 0], k1).astype(jnp.float32)
        s2 = jnp.einsum('bhqd,bhkd->bhqk', qblk[:, :, 1], k2).astype(jnp.float32)
        p1 = jax.nn.softmax(jnp.where(causal, s1, NEG_INF), axis=-1)
        p2 = jax.nn.softmax(jnp.where(causal, s2, NEG_INF), axis=-1)
        w = (p1 - lam32 * p2).astype(vh.dtype)
        return jnp.einsum('bhqk,bhkd->bhqd', w, vh)

    out = lax.map(one_block, (qb, jnp.arange(nb) * Q_BLOCK))
    return out.transpose(1, 0, 3, 2, 4).reshape(b, s, N_DIFF_HEADS, DIFF_V_DIM)


def chunked_spatial_gating(u, v, ws, bs, ln_g, ln_b):
    b, s = u.shape[0], u.shape[1]
    vn = layer_norm(v, ln_g, ln_b)
    vc = vn.reshape(b, s // CHUNK, CHUNK, N_GMLP_GROUPS, GMLP_GROUP_DIM)
    causal = jnp.tril(jnp.ones((CHUNK, CHUNK), dtype=bool))
    w = jnp.where(causal[None], ws, 0)
    mixed = jnp.einsum('gts,bnsgc->bntgc', w, vc) + bs.T[None, None, :, :, None]
    return (u * mixed.reshape(b, s, N_GMLP_GROUPS, GMLP_GROUP_DIM)).reshape(b, s, D_GMLP)


def cross_attention(hn, mem_n, wq, wkv, wo):
    b, s = hn.shape[0], hn.shape[1]
    m = mem_n.shape[1]
    q = (hn @ wq).reshape(b, s, N_CROSS_HEADS, CROSS_HEAD_DIM)
    kv = (mem_n @ wkv).reshape(b, m, 2, N_CROSS_HEADS, CROSS_HEAD_DIM)
    sc = jnp.einsum('bshd,bmhd->bhsm', q, kv[:, :, 0]).astype(jnp.float32) * (CROSS_HEAD_DIM ** -0.5)
    p = jax.nn.softmax(sc, axis=-1).astype(hn.dtype)
    o = jnp.einsum('bhsm,bmhd->bshd', p, kv[:, :, 1]).reshape(b, s, D_MODEL)
    return o @ wo


def setup_inputs(seed: int = 0) -> dict:
    key = jax.random.key(seed)
    ks = jax.random.split(key, 32)
    f32 = jnp.float32

    def nrm(k, shape, fan_in):
        return jax.random.normal(k, shape, f32) * (fan_in ** -0.5)

    def gain(k, shape):
        return 1.0 + 0.02 * jax.random.normal(k, shape, f32)

    L = DEPTH
    return {
        'x': jax.random.normal(ks[0], (BATCH, SEQ, D_MODEL), f32),
        'mem': jax.random.normal(ks[1], (BATCH, N_MEM, D_MODEL), f32),
        'positions': jnp.broadcast_to(jnp.arange(SEQ, dtype=jnp.int32)[None, :], (BATCH, SEQ)),
        'ffn1_norm': gain(ks[2], (L, D_MODEL)),
        'ffn1_wgu': nrm(ks[3], (L, D_MODEL, 2 * D_FF), D_MODEL),
        'ffn1_wd': nrm(ks[4], (L, D_FF, D_MODEL), D_FF),
        'mix_norm': gain(ks[5], (L, D_MODEL)),
        'w_in': nrm(ks[6], (L, D_MODEL, D_IN), D_MODEL),
        'lam_q1': 0.1 * jax.random.normal(ks[7], (L, DIFF_QK_DIM), f32),
        'lam_k1': 0.1 * jax.random.normal(ks[8], (L, DIFF_QK_DIM), f32),
        'lam_q2': 0.1 * jax.random.normal(ks[9], (L, DIFF_QK_DIM), f32),
        'lam_k2': 0.1 * jax.random.normal(ks[10], (L, DIFF_QK_DIM), f32),
        'subln': gain(ks[11], (L, DIFF_V_DIM)),
        'gmlp_ln_g': gain(ks[12], (L, N_GMLP_GROUPS, GMLP_GROUP_DIM)),
        'gmlp_ln_b': 0.02 * jax.random.normal(ks[13], (L, N_GMLP_GROUPS, GMLP_GROUP_DIM), f32),
        'gmlp_ws': nrm(ks[14], (L, N_GMLP_GROUPS, CHUNK, CHUNK), CHUNK),
        'gmlp_bs': gain(ks[15], (L, N_GMLP_GROUPS, CHUNK)),
        'w_out': nrm(ks[16], (L, D_MIX, D_MODEL), D_MIX),
        'cross_norm': gain(ks[17], (L, D_MODEL)),
        'mem_norm': gain(ks[18], (L, D_MODEL)),
        'cross_wq': nrm(ks[19], (L, D_MODEL, D_MODEL), D_MODEL),
        'cross_wkv': nrm(ks[20], (L, D_MODEL, 2 * D_MODEL), D_MODEL),
        'cross_wo': nrm(ks[21], (L, D_MODEL, D_MODEL), D_MODEL),
        'ffn2_norm': gain(ks[22], (L, D_MODEL)),
        'ffn2_wgu': nrm(ks[23], (L, D_MODEL, 2 * D_FF), D_MODEL),
        'ffn2_wd': nrm(ks[24], (L, D_FF, D_MODEL), D_FF),
        'final_norm': gain(ks[25], (D_MODEL,)),
    }


def reference(x, mem, positions, ffn1_norm, ffn1_wgu, ffn1_wd, mix_norm, w_in,
              lam_q1, lam_k1, lam_q2, lam_k2, subln, gmlp_ln_g, gmlp_ln_b, gmlp_ws,
              gmlp_bs, w_out, cross_norm, mem_norm, cross_wq, cross_wkv, cross_wo,
              ffn2_norm, ffn2_wgu, ffn2_wd, final_norm):
    b, s = x.shape[0], x.shape[1]
    cos, sin = rope_tables(positions)
    h = x
    for i in range(DEPTH):
        h = h + 0.5 * swiglu(rms_norm(h, ffn1_norm[i]), ffn1_wgu[i], ffn1_wd[i])

        hn = rms_norm(h, mix_norm[i])
        proj = hn @ w_in[i]
        q, k, v, gu, gv = jnp.split(
            proj, [D_DIFF, 2 * D_DIFF, 3 * D_DIFF, 3 * D_DIFF + D_GMLP], axis=-1)
        q = partial_rope(q.reshape(b, s, N_DIFF_HEADS, 2, DIFF_QK_DIM), cos, sin)
        k = partial_rope(k.reshape(b, s, N_DIFF_HEADS, 2, DIFF_QK_DIM), cos, sin)
        v = v.reshape(b, s, N_DIFF_HEADS, DIFF_V_DIM)
        lam_init = 0.8 - 0.6 * math.exp(-0.3 * i)
        lam = (jnp.exp(jnp.sum(lam_q1[i].astype(jnp.float32) * lam_k1[i].astype(jnp.float32)))
               - jnp.exp(jnp.sum(lam_q2[i].astype(jnp.float32) * lam_k2[i].astype(jnp.float32)))
               + lam_init)
        attn = diff_attention(q, k, v, lam)
        attn = (rms_norm(attn, subln[i]) * (1.0 - lam_init)).reshape(b, s, D_DIFF)

        gu = jax.nn.gelu(gu, approximate=False).reshape(b, s, N_GMLP_GROUPS, GMLP_GROUP_DIM)
        gv = jax.nn.gelu(gv, approximate=False).reshape(b, s, N_GMLP_GROUPS, GMLP_GROUP_DIM)
        gm = chunked_spatial_gating(gu, gv, gmlp_ws[i], gmlp_bs[i], gmlp_ln_g[i], gmlp_ln_b[i])

        h = h + jnp.concatenate([attn, gm], axis=-1) @ w_out[i]

        h = h + cross_attention(rms_norm(h, cross_norm[i]), rms_norm(mem, mem_norm[i]),
                                cross_wq[i], cross_wkv[i], cross_wo[i])

        h = h + 0.5 * swiglu(rms_norm(h, ffn2_norm[i]), ffn2_wgu[i], ffn2_wd[i])
    return rms_norm(h, final_norm)
```

```cpp
#include <hip/hip_runtime.h>
#include <cstdio>
#include <cstdint>
namespace pg8 {
#define PG8_LAS __attribute__((address_space(3)))
typedef unsigned short bf16_t;
typedef short bf16x8 __attribute__((ext_vector_type(8)));
typedef float f32x4 __attribute__((ext_vector_type(4)));
typedef float f32x2 __attribute__((ext_vector_type(2)));
typedef unsigned u32x4 __attribute__((ext_vector_type(4)));
typedef unsigned u32x2 __attribute__((ext_vector_type(2)));
constexpr int BM = 256, BK = 64, HALF = 128, HTB = HALF * BK * 2  , STAGE_BYTES = 8 * HTB, NXCD = 8, WGM = 8;

__host__ __device__ __forceinline__ int lds_byte(int r, int c) { const int st = (r >> 4) * 2 + (c >> 5), rr = r & 15, cc = c & 31, ob = rr * 64 + cc * 2; return st * 1024 + (ob ^ (((ob >> 9) & 1) << 5)); }
__host__ __device__ __forceinline__ void stage_rc(int b, int& R, int& C) { const int st = b / 1024, sb = b % 1024, swz = sb ^ (((sb >> 9) & 1) << 5); R = (st >> 1) * 16 + swz / 64; C = (st & 1) * 32 + (swz % 64) / 2; }
__host__ __device__ __forceinline__ int perm32(int rho) { const int n = rho >> 4, i = rho & 15; return 8 * (i >> 2) + 4 * n + (i & 3); }

struct Unit { int pm, pn; };
struct Gemm { const bf16_t* A; const bf16_t* Bt; int lda, ldb, K; long a_pn, b_pn, b_batch; };
__device__ __forceinline__ Gemm make_gemm(const bf16_t* A, const bf16_t* Bt, int K) { Gemm g; g.A = A; g.Bt = Bt; g.lda = K; g.ldb = K; g.K = K; g.a_pn = 0; g.b_pn = (long)BM * K; g.b_batch = 0; return g; }

struct StaticOrder {
    int nM, nN, nwg, G, c;
    __host__ __device__ void init(int M, int N, int G_, int c_) { nM = M / BM; nN = N / BM; nwg = nM * nN; G = G_; c = c_; }
    __host__ __device__ bool next(int i, Unit& u) const {
        const long L = (long)i * G + c; if (L >= nwg) return false;
        int wgid = (int)L; { const int q = nwg / NXCD, r = nwg % NXCD, xcd = wgid % NXCD, off = wgid / NXCD; wgid = (xcd < r ? xcd * (q + 1) : r * (q + 1) + (xcd - r) * q) + off; }
        const int nig = WGM * nN, gid = wgid / nig, fm = gid * WGM, gsz = (nM - fm) < WGM ? (nM - fm) : WGM;
        u.pm = fm + ((wgid % nig) % gsz); u.pn = (wgid % nig) / gsz; return true;
    }
    __device__ __forceinline__ void a_ready(const Unit&) const {}
    __device__ __forceinline__ void done(const Unit&) const {}
};
struct KvOrder {
    int j;
    __device__ __forceinline__ bool next(int i, Unit& u) const { if (i != 0 || j < 0 || j >= 32) return false; u.pm = j & 1; u.pn = j >> 1; return true; }
    __device__ __forceinline__ void a_ready(const Unit&) const {}
    __device__ __forceinline__ void done(const Unit&) const {}
};

__device__ __forceinline__ unsigned cvt_pk_bf16(float lo, float hi) { unsigned r; asm volatile("v_cvt_pk_bf16_f32 %0, %1, %2" : "=v"(r) : "v"(lo), "v"(hi)); return r; }
__device__ __forceinline__ f32x2 gelu_pk(f32x2 v) {
    const f32x2 av = __builtin_elementwise_abs(v), d = av * 0.2316418882f + 1.0f;
    f32x2 t; t.x = __builtin_amdgcn_rcpf(d.x); t.y = __builtin_amdgcn_rcpf(d.y);
    f32x2 q = t * 0.5307027145f + (-0.7265760135f); q = q * t + 0.7107068705f; q = q * t + (-0.142248368f); q = q * t + 0.127414796f; q = q * t;
    const f32x2 s = (v * v) * (-0.72134752044f);
    f32x2 e; e.x = __builtin_amdgcn_exp2f(s.x); e.y = __builtin_amdgcn_exp2f(s.y);
    const f32x2 m = v * (q * e), r = v - m;
    f32x2 o; o.x = v.x < 0.f ? m.x : r.x; o.y = v.y < 0.f ? m.y : r.y; return o;
}
__device__ __forceinline__ f32x4 gelu4(f32x4 v) { const f32x2 a = gelu_pk((f32x2){v[0], v[1]}), b = gelu_pk((f32x2){v[2], v[3]}); return (f32x4){a.x, a.y, b.x, b.y}; }
__device__ __forceinline__ float silu1(float g) { return g * __builtin_amdgcn_rcpf(1.0f + __builtin_amdgcn_exp2f(g * -1.4426950408889634f)); }
__device__ __forceinline__ float rs_from_stats(const float* stats, int row) { const f32x4 s = *(const f32x4*)(stats + (size_t)row * 4); return __builtin_amdgcn_rsqf(((s[0] + s[1]) + (s[2] + s[3])) * (1.0f / 1024.0f) + 1e-6f); }


struct EpiSwiGLU {
    static constexpr bool PERM = true, AFTER_DRAIN = false;
    bf16_t* O; int ldc; const float* stats;
    __device__ __forceinline__ void operator()(const f32x4 (&acc)[2][2][4][2], const Unit& u, int wr, int wc, int fr, int fq) const {
        const int row0 = u.pm * BM + wr * 64 + fr, col0 = u.pn * HALF + wc * 32 + 8 * fq;
#pragma unroll
        for (int ai = 0; ai < 2; ++ai)
#pragma unroll
            for (int m = 0; m < 4; ++m) { const int row = row0 + ai * HALF + m * 16; const float r = rs_from_stats(stats, row);
                u32x4 w; unsigned ww[4];
#pragma unroll
                for (int n = 0; n < 2; ++n) { const f32x4 g = acc[ai][0][m][n] * r, up = acc[ai][1][m][n] * r;
                    ww[2 * n] = cvt_pk_bf16(silu1(g[0]) * up[0], silu1(g[1]) * up[1]); ww[2 * n + 1] = cvt_pk_bf16(silu1(g[2]) * up[2], silu1(g[3]) * up[3]); }
                w.x = ww[0]; w.y = ww[1]; w.z = ww[2]; w.w = ww[3];
                *(u32x4*)(O + (size_t)row * ldc + col0) = w; }
    }
};

struct EpiWin {
    static constexpr bool PERM = true, AFTER_DRAIN = false;
    bf16_t* O5; size_t ostride; const float* stats; const float* cs; float qscale;
    __device__ __forceinline__ void operator()(const f32x4 (&acc)[2][2][4][2], const Unit& u, int wr, int wc, int fr, int fq) const {
        const int typ = u.pn >> 1; bf16_t* base = O5 + (size_t)typ * ostride;
        const int row0 = u.pm * BM + wr * 64 + fr, col0 = (u.pn & 1) * BM + wc * 32 + 8 * fq;
        const bool rot = (typ < 2) && ((wc & 1) == 0);
        const float sgn = (fq == 0) ? -1.0f : 1.0f; const bool rl = fq < 2; const float qs = (typ == 0) ? qscale : 1.0f;
#pragma unroll
        for (int ai = 0; ai < 2; ++ai)
#pragma unroll
            for (int m = 0; m < 4; ++m) { const int row = row0 + ai * HALF + m * 16; const float r = rs_from_stats(stats, row);
                f32x4 cc[2], sn[2];
                if (rot) { cc[0] = *(const f32x4*)(cs + (size_t)row * 16); cc[1] = *(const f32x4*)(cs + (size_t)row * 16 + 4); sn[0] = *(const f32x4*)(cs + (size_t)row * 16 + 8); sn[1] = *(const f32x4*)(cs + (size_t)row * 16 + 12); }
#pragma unroll
                for (int bj = 0; bj < 2; ++bj) { f32x4 v0 = acc[ai][bj][m][0] * r, v1 = acc[ai][bj][m][1] * r;
                    if (rot) {
                        f32x4 p0, p1;
#pragma unroll
                        for (int i = 0; i < 4; ++i) { p0[i] = __shfl_xor(v0[i], 16); p1[i] = __shfl_xor(v1[i], 16); }
                        const f32x4 n0 = v0 * cc[0] + (p0 * sn[0]) * sgn, n1 = v1 * cc[1] + (p1 * sn[1]) * sgn;
                        if (rl) { v0 = n0; v1 = n1; }
                    }
                    if (typ >= 3) { v0 = gelu4(v0); v1 = gelu4(v1); }
                    v0 = v0 * qs; v1 = v1 * qs;
                    u32x4 w; w.x = cvt_pk_bf16(v0[0], v0[1]); w.y = cvt_pk_bf16(v0[2], v0[3]); w.z = cvt_pk_bf16(v1[0], v1[1]); w.w = cvt_pk_bf16(v1[2], v1[3]);
                    *(u32x4*)(base + (size_t)row * 512 + col0 + bj * HALF) = w; } }
    }
};

struct EpiRowBf16 {
    static constexpr bool PERM = true, AFTER_DRAIN = false;
    bf16_t* O; int ldc; const float* stats; float sc;
    __device__ __forceinline__ void operator()(const f32x4 (&acc)[2][2][4][2], const Unit& u, int wr, int wc, int fr, int fq) const {
        const int row0 = u.pm * BM + wr * 64 + fr, col0 = u.pn * BM + wc * 32 + 8 * fq;
#pragma unroll
        for (int ai = 0; ai < 2; ++ai)
#pragma unroll
            for (int m = 0; m < 4; ++m) { const int row = row0 + ai * HALF + m * 16; const float r = (stats ? rs_from_stats(stats, row) : 1.0f) * sc;
#pragma unroll
                for (int bj = 0; bj < 2; ++bj) { const f32x4 v0 = acc[ai][bj][m][0] * r, v1 = acc[ai][bj][m][1] * r;
                    u32x4 w; w.x = cvt_pk_bf16(v0[0], v0[1]); w.y = cvt_pk_bf16(v0[2], v0[3]); w.z = cvt_pk_bf16(v1[0], v1[1]); w.w = cvt_pk_bf16(v1[2], v1[3]);
                    *(u32x4*)(O + (size_t)row * ldc + col0 + bj * HALF) = w; } }
    }
};

struct EpiKV {
    static constexpr bool PERM = true, AFTER_DRAIN = false;
    bf16_t* Kc; bf16_t* VcT;
    __device__ __forceinline__ void operator()(const f32x4 (&acc)[2][2][4][2], const Unit& u, int wr, int wc, int fr, int fq) const {
        const int layer = u.pn >> 3, t = u.pn & 7;
        const int row0 = u.pm * BM + wr * 64 + fr;
        if (t < 4) {
            bf16_t* base = Kc + (size_t)layer * 512 * 1024; const int col0 = t * BM + wc * 32 + 8 * fq;
#pragma unroll
            for (int ai = 0; ai < 2; ++ai)
#pragma unroll
                for (int m = 0; m < 4; ++m) { const int row = row0 + ai * HALF + m * 16;
#pragma unroll
                    for (int bj = 0; bj < 2; ++bj) { const f32x4 v0 = acc[ai][bj][m][0], v1 = acc[ai][bj][m][1];
                        u32x4 w; w.x = cvt_pk_bf16(v0[0], v0[1]); w.y = cvt_pk_bf16(v0[2], v0[3]); w.z = cvt_pk_bf16(v1[0], v1[1]); w.w = cvt_pk_bf16(v1[2], v1[3]);
                        *(u32x4*)(base + (size_t)row * 1024 + col0 + bj * HALF) = w; } }
        } else {
            bf16_t* base = VcT + ((size_t)layer * 2 + u.pm) * 1024 * 256; const int col0 = (t - 4) * BM + wc * 32 + 8 * fq;
#pragma unroll
            for (int ai = 0; ai < 2; ++ai)
#pragma unroll
                for (int m = 0; m < 4; ++m) { const int key = wr * 64 + fr + ai * HALF + m * 16;
#pragma unroll
                    for (int bj = 0; bj < 2; ++bj)
#pragma unroll
                        for (int n = 0; n < 2; ++n) { const f32x4 v = acc[ai][bj][m][n];
                            const unsigned lo = cvt_pk_bf16(v[0], v[1]), hi = cvt_pk_bf16(v[2], v[3]); bf16_t* p = base + (size_t)(col0 + bj * HALF + 4 * n) * 256 + key;
                            p[0] = (bf16_t)(lo & 0xffffu); p[256] = (bf16_t)(lo >> 16); p[512] = (bf16_t)(hi & 0xffffu); p[768] = (bf16_t)(hi >> 16); } }
        }
    }
};

struct EpiResid {
    static constexpr bool PERM = false, AFTER_DRAIN = true;
    const float* hin; float* hout; bf16_t* hb; float* stats; float alpha;
    __device__ __forceinline__ void fused(f32x4 (&acc)[2][2][4][2], const Unit& u, int wr, int wc, int fr, int fq, PG8_LAS unsigned char* lds, int wid, int lane) const {
        PG8_LAS float* P = (PG8_LAS float*)lds;
        const int col0 = u.pn * BM + wc * 32 + 4 * fq;
#pragma unroll
        for (int ai = 0; ai < 2; ++ai)
#pragma unroll
            for (int m = 0; m < 4; ++m) { const int rl = ai * HALF + wr * 64 + m * 16 + fr; const size_t off = (size_t)(u.pm * BM + rl) * 1024 + col0; float ss = 0.f;
#pragma unroll
                for (int bj = 0; bj < 2; ++bj)
#pragma unroll
                    for (int n = 0; n < 2; ++n) { const f32x4 hv = *(const f32x4*)(hin + off + bj * HALF + n * 16); const f32x4 o = hv + acc[ai][bj][m][n] * alpha;
                        *(f32x4*)(hout + off + bj * HALF + n * 16) = o; u32x2 w; w.x = cvt_pk_bf16(o[0], o[1]); w.y = cvt_pk_bf16(o[2], o[3]); *(u32x2*)(hb + off + bj * HALF + n * 16) = w;
                        ss += (o[0] * o[0] + o[1] * o[1]) + (o[2] * o[2] + o[3] * o[3]); }
                ss += __shfl_xor(ss, 16); ss += __shfl_xor(ss, 32);
                if (fq == 0) P[rl * 4 + wc] = ss;
                if (m & 1) asm volatile("" ::: "memory"); }
        asm volatile("s_waitcnt lgkmcnt(0)" ::: "memory"); __builtin_amdgcn_s_barrier(); asm volatile("" ::: "memory");
        const int tid = wid * 64 + lane;
        if (tid < 256) { const f32x4 p = *(const PG8_LAS f32x4*)(P + tid * 4); stats[(size_t)(u.pm * BM + tid) * 4 + u.pn] = (p[0] + p[1]) + (p[2] + p[3]); }
        asm volatile("s_waitcnt lgkmcnt(0)" ::: "memory"); __builtin_amdgcn_s_barrier(); asm volatile("" ::: "memory");
    }
};

struct EpiScores {
    static constexpr bool PERM = true, AFTER_DRAIN = true;
    bf16_t* Pm;
    __device__ __forceinline__ void fused(f32x4 (&acc)[2][2][4][2], const Unit& u, int wr, int wc, int fr, int fq, PG8_LAS unsigned char* lds, int wid, int lane) const {
        PG8_LAS float* PX = (PG8_LAS float*)lds;
        PG8_LAS float* PS = (PG8_LAS float*)(lds + 4096);
        float mx[2][4];
#pragma unroll
        for (int ai = 0; ai < 2; ++ai)
#pragma unroll
            for (int m = 0; m < 4; ++m) { float a = -3.0e38f;
#pragma unroll
                for (int bj = 0; bj < 2; ++bj)
#pragma unroll
                    for (int n = 0; n < 2; ++n) { const f32x4 x = acc[ai][bj][m][n]; a = fmaxf(a, fmaxf(fmaxf(x[0], x[1]), fmaxf(x[2], x[3]))); }
                a = fmaxf(a, __shfl_xor(a, 16)); a = fmaxf(a, __shfl_xor(a, 32));
                if (fq == 0) PX[(ai * HALF + wr * 64 + m * 16 + fr) * 4 + wc] = a; }
        asm volatile("s_waitcnt lgkmcnt(0)" ::: "memory"); __builtin_amdgcn_s_barrier(); asm volatile("" ::: "memory");
#pragma unroll
        for (int ai = 0; ai < 2; ++ai)
#pragma unroll
            for (int m = 0; m < 4; ++m) { const int rl = ai * HALF + wr * 64 + m * 16 + fr; const f32x4 p = *(const PG8_LAS f32x4*)(PX + rl * 4);
                const float mrow = fmaxf(fmaxf(p[0], p[1]), fmaxf(p[2], p[3])); mx[ai][m] = mrow; float s = 0.f;
#pragma unroll
                for (int bj = 0; bj < 2; ++bj)
#pragma unroll
                    for (int n = 0; n < 2; ++n) { f32x4 x = acc[ai][bj][m][n];
#pragma unroll
                        for (int i = 0; i < 4; ++i) { x[i] = __builtin_amdgcn_exp2f(x[i] - mrow); s += x[i]; }
                        acc[ai][bj][m][n] = x; }
                s += __shfl_xor(s, 16); s += __shfl_xor(s, 32);
                if (fq == 0) PS[rl * 4 + wc] = s; }
        asm volatile("s_waitcnt lgkmcnt(0)" ::: "memory"); __builtin_amdgcn_s_barrier(); asm volatile("" ::: "memory");
        const int col0 = u.pn * BM + wc * 32 + 8 * fq;
#pragma unroll
        for (int ai = 0; ai < 2; ++ai)
#pragma unroll
            for (int m = 0; m < 4; ++m) { const int rl = ai * HALF + wr * 64 + m * 16 + fr; const f32x4 p = *(const PG8_LAS f32x4*)(PS + rl * 4);
                const float inv = __builtin_amdgcn_rcpf((p[0] + p[1]) + (p[2] + p[3]));
#pragma unroll
                for (int bj = 0; bj < 2; ++bj) { const f32x4 v0 = acc[ai][bj][m][0] * inv, v1 = acc[ai][bj][m][1] * inv;
                    u32x4 w; w.x = cvt_pk_bf16(v0[0], v0[1]); w.y = cvt_pk_bf16(v0[2], v0[3]); w.z = cvt_pk_bf16(v1[0], v1[1]); w.w = cvt_pk_bf16(v1[2], v1[3]);
                    *(u32x4*)(Pm + (size_t)(u.pm * BM + rl) * 1024 + col0 + bj * HALF) = w; } }
        asm volatile("s_waitcnt lgkmcnt(0)" ::: "memory"); __builtin_amdgcn_s_barrier(); asm volatile("" ::: "memory");
        (void)mx;
    }
};

template <class Epi, class Sched, bool ALIGN_EPI = false, bool SP2 = false>
__device__ __forceinline__ void gemm_phase(PG8_LAS unsigned char* lds, const Gemm g, const Sched& S, const Epi& E) {
    int tid_ = threadIdx.x; asm volatile("" : "+v"(tid_));
    int wid_ = __builtin_amdgcn_readfirstlane(tid_ >> 6); asm volatile("" : "+s"(wid_));
    const int tid = tid_, wid = wid_, lane = tid & 63, wr = wid >> 2, wc = wid & 3, fr = lane & 15, fq = lane >> 4;
    const int K = g.K, nt = K / BK;
    unsigned voffA[2], voffB[2];
#pragma unroll
    for (int i = 0; i < 2; ++i) { int R, C; stage_rc(tid * 16 + i * 8192, R, C); const int Rb = Epi::PERM ? ((R & ~31) + perm32(R & 31)) : R;
        voffA[i] = (unsigned)(R * g.lda + C) * 2u; voffB[i] = (unsigned)(Rb * g.ldb + C) * 2u; }
    const size_t kstep = (size_t)(BK * 2);
    const size_t hstepA = (size_t)HALF * g.lda * 2, hstepB = (size_t)HALF * g.ldb * 2;
    const unsigned ldsw = (unsigned)wid * 1024u;
    const int aoff = lds_byte(wr * 64 + fr, fq * 8), boff = lds_byte(wc * 32 + fr, fq * 8);
#define PG8_ABASE(u) ((const char*)(g.A + ((size_t)(u).pm * BM * g.lda + (size_t)(u).pn * g.a_pn)))
#define PG8_BBASE(u) ((const char*)(g.Bt + ((size_t)(u).pn * g.b_pn + (size_t)((u).pm >> 5) * g.b_batch)))
#define PG8_SA(b, h) (((b) * 2 + (h)) * HTB)
#define PG8_SB(b, h) ((4 + (b) * 2 + (h)) * HTB)
#define PG8_STAGE(bufoff, gbase, voff) do { _Pragma("unroll") for (int _i = 0; _i < 2; ++_i) \
        __builtin_amdgcn_global_load_lds((const unsigned*)((const char*)(gbase) + (voff)[_i]), (PG8_LAS unsigned*)(lds + (bufoff) + ldsw + _i * 8192), 16, 0, 0); } while (0)
#define PG8_LDA(dst, b, h) do { _Pragma("unroll") for (int m = 0; m < 4; ++m) _Pragma("unroll") for (int k = 0; k < 2; ++k) dst[m][k] = *(const PG8_LAS bf16x8*)(lds + PG8_SA(b, h) + aoff + m * 2048 + k * 1024); } while (0)
#define PG8_LDB(dst, b, h) do { _Pragma("unroll") for (int n = 0; n < 2; ++n) _Pragma("unroll") for (int k = 0; k < 2; ++k) dst[n][k] = *(const PG8_LAS bf16x8*)(lds + PG8_SB(b, h) + boff + n * 2048 + k * 1024); } while (0)
#define PG8_MMA(ai, bj, At, Bt) do { __builtin_amdgcn_s_setprio(1); _Pragma("unroll") for (int m = 0; m < 4; ++m) _Pragma("unroll") for (int n = 0; n < 2; ++n) _Pragma("unroll") for (int k = 0; k < 2; ++k) \
        acc[ai][bj][m][n] = __builtin_amdgcn_mfma_f32_16x16x32_bf16(Bt[n][k], At[m][k], acc[ai][bj][m][n], 0, 0, 0); __builtin_amdgcn_s_setprio(0); } while (0)
#define PG8_WAIT_V(n) asm volatile("s_waitcnt vmcnt(" #n ")" ::: "memory")
#define PG8_WAIT_L(n) asm volatile("s_waitcnt lgkmcnt(" #n ")" ::: "memory")
#define PG8_BAR __builtin_amdgcn_s_barrier()
#define PG8_SCHED __builtin_amdgcn_sched_barrier(0)
    Unit cur, nxt; int ui = 0;
    if (!S.next(0, cur)) return;
    f32x4 acc[2][2][4][2];
#pragma unroll
    for (int a = 0; a < 2; ++a)
#pragma unroll
        for (int b = 0; b < 2; ++b)
#pragma unroll
            for (int m = 0; m < 4; ++m)
#pragma unroll
                for (int n = 0; n < 2; ++n) acc[a][b][m][n] = (f32x4){0.f, 0.f, 0.f, 0.f};
    bf16x8 At[4][2], B0[2][2], B1[2][2];
    const char* cA = PG8_ABASE(cur); const char* cB = PG8_BBASE(cur);
    S.a_ready(cur);
    if constexpr (SP2) {
        PG8_STAGE(PG8_SB(0, 0), cB, voffB); PG8_STAGE(PG8_SB(0, 1), cB + hstepB, voffB); PG8_STAGE(PG8_SA(0, 0), cA, voffA); PG8_STAGE(PG8_SA(0, 1), cA + hstepA, voffA);
        if (wr == 1) PG8_BAR;
        PG8_WAIT_V(2); PG8_BAR;
        PG8_STAGE(PG8_SB(1, 0), cB + kstep, voffB); PG8_STAGE(PG8_SA(1, 0), cA + kstep, voffA); PG8_STAGE(PG8_SB(1, 1), cB + hstepB + kstep, voffB);
        PG8_WAIT_V(6); PG8_BAR;
    } else {
        PG8_STAGE(PG8_SB(0, 0), cB, voffB); PG8_STAGE(PG8_SA(0, 0), cA, voffA); PG8_STAGE(PG8_SB(0, 1), cB + hstepB, voffB); PG8_STAGE(PG8_SA(0, 1), cA + hstepA, voffA);
        if (wr == 1) PG8_BAR;
        PG8_WAIT_V(4); PG8_BAR;
        PG8_STAGE(PG8_SB(1, 0), cB + kstep, voffB); PG8_STAGE(PG8_SA(1, 0), cA + kstep, voffA); PG8_STAGE(PG8_SB(1, 1), cB + hstepB + kstep, voffB);
        PG8_WAIT_V(6); PG8_BAR;
    }
    for (;;) {
        const bool has_next = S.next(ui + 1, nxt);
        const char* nA = has_next ? PG8_ABASE(nxt) : cA; const char* nB = has_next ? PG8_BBASE(nxt) : cB;
        for (int t = 0; t < nt; t += 2) {
            const bool last = (t == nt - 2);
            const char* a1 = cA + (size_t)(t + 1) * kstep;
            const char* a2 = last ? nA : cA + (size_t)(t + 2) * kstep; const char* b2 = last ? nB : cB + (size_t)(t + 2) * kstep;
            const char* a3 = a2 + kstep; const char* b3 = b2 + kstep;
            if (last && has_next) S.a_ready(nxt);
            if constexpr (SP2) {
            PG8_LDB(B0, 0, 0); PG8_LDB(B1, 0, 1); PG8_SCHED; PG8_LDA(At, 0, 0); PG8_STAGE(PG8_SA(1, 1), a1 + hstepA, voffA);
            PG8_WAIT_V(8); PG8_WAIT_L(0); PG8_BAR; PG8_MMA(0, 0, At, B0); PG8_MMA(0, 1, At, B1); PG8_BAR; PG8_SCHED;
            PG8_LDA(At, 0, 1); PG8_STAGE(PG8_SB(0, 0), b2, voffB); PG8_STAGE(PG8_SB(0, 1), b2 + hstepB, voffB); PG8_STAGE(PG8_SA(0, 0), a2, voffA);
            PG8_WAIT_V(8); PG8_WAIT_L(0); PG8_BAR; PG8_MMA(1, 0, At, B0); PG8_MMA(1, 1, At, B1); PG8_BAR; PG8_SCHED;
            PG8_LDB(B0, 1, 0); PG8_LDB(B1, 1, 1); PG8_SCHED; PG8_LDA(At, 1, 0); PG8_STAGE(PG8_SA(0, 1), a2 + hstepA, voffA);
            PG8_WAIT_V(8); PG8_WAIT_L(0); PG8_BAR; PG8_MMA(0, 0, At, B0); PG8_MMA(0, 1, At, B1); PG8_BAR; PG8_SCHED;
            PG8_LDA(At, 1, 1); PG8_STAGE(PG8_SB(1, 0), b3, voffB); PG8_STAGE(PG8_SB(1, 1), b3 + hstepB, voffB); PG8_STAGE(PG8_SA(1, 0), a3, voffA);
            PG8_WAIT_V(8); PG8_WAIT_L(0); PG8_BAR; PG8_MMA(1, 0, At, B0); PG8_MMA(1, 1, At, B1); PG8_BAR; PG8_SCHED;
            } else {
            PG8_LDB(B0, 0, 0); PG8_SCHED; PG8_LDA(At, 0, 0); PG8_STAGE(PG8_SA(1, 1), a1 + hstepA, voffA);
            PG8_WAIT_L(8); PG8_BAR; PG8_WAIT_L(0); PG8_MMA(0, 0, At, B0); PG8_BAR; PG8_SCHED;
            PG8_LDB(B1, 0, 1); PG8_STAGE(PG8_SB(0, 0), b2, voffB);
            PG8_BAR; PG8_WAIT_L(0); PG8_MMA(0, 1, At, B1); PG8_BAR;
            PG8_LDA(At, 0, 1); PG8_STAGE(PG8_SA(0, 0), a2, voffA);
            PG8_BAR; PG8_WAIT_L(0); PG8_MMA(1, 0, At, B0); PG8_BAR; PG8_SCHED;
            PG8_STAGE(PG8_SB(0, 1), b2 + hstepB, voffB);
            PG8_WAIT_V(6); PG8_BAR; PG8_MMA(1, 1, At, B1); PG8_BAR;
            PG8_LDB(B0, 1, 0); PG8_SCHED; PG8_LDA(At, 1, 0); PG8_STAGE(PG8_SA(0, 1), a2 + hstepA, voffA);
            PG8_WAIT_L(8); PG8_BAR; PG8_WAIT_L(0); PG8_MMA(0, 0, At, B0); PG8_BAR; PG8_SCHED;
            PG8_LDB(B1, 1, 1); PG8_STAGE(PG8_SB(1, 0), b3, voffB);
            PG8_BAR; PG8_WAIT_L(0); PG8_MMA(0, 1, At, B1); PG8_BAR;
            PG8_LDA(At, 1, 1); PG8_STAGE(PG8_SA(1, 0), a3, voffA);
            PG8_BAR; PG8_WAIT_L(0); PG8_MMA(1, 0, At, B0); PG8_BAR; PG8_SCHED;
            PG8_STAGE(PG8_SB(1, 1), b3 + hstepB, voffB);
            PG8_WAIT_V(6); PG8_BAR; PG8_MMA(1, 1, At, B1); PG8_BAR;
            }
        }
        if constexpr (ALIGN_EPI) { if (wr == 0) PG8_BAR; }
        if constexpr (!Epi::AFTER_DRAIN) { E(acc, cur, wr, wc, fr, fq); S.done(cur); }
        if (!has_next) break;
#pragma unroll
        for (int a = 0; a < 2; ++a)
#pragma unroll
            for (int b = 0; b < 2; ++b)
#pragma unroll
                for (int m = 0; m < 4; ++m)
#pragma unroll
                    for (int n = 0; n < 2; ++n) acc[a][b][m][n] = (f32x4){0.f, 0.f, 0.f, 0.f};
        cur = nxt; cA = nA; cB = nB; ++ui;
        if constexpr (ALIGN_EPI) { if (wr == 1) PG8_BAR; }
    }
    PG8_WAIT_V(0);
    if constexpr (!ALIGN_EPI) { if (wr == 0) PG8_BAR; }
    PG8_BAR;
    if constexpr (Epi::AFTER_DRAIN) { E.fused(acc, cur, wr, wc, fr, fq, lds, wid, lane); S.done(cur); }
#undef PG8_ABASE
#undef PG8_BBASE
#undef PG8_SA
#undef PG8_SB
#undef PG8_STAGE
#undef PG8_LDA
#undef PG8_LDB
#undef PG8_MMA
#undef PG8_WAIT_V
#undef PG8_WAIT_L
#undef PG8_BAR
#undef PG8_SCHED
}
}
#include <hip/hip_bf16.h>
#include <cmath>
namespace attn_body {
using bf16=__hip_bfloat16;
using bf16x8=__attribute__((ext_vector_type(8)))short;
using s16x4=__attribute__((ext_vector_type(4)))short;
using f32x16=__attribute__((ext_vector_type(16)))float;
using u32x4=__attribute__((ext_vector_type(4)))unsigned;
constexpr int BATCH=2,NHEAD=16,SEQ=8192,D=64,QKP=512,OP=1024;
constexpr int NW=8,QBLK=32,QB=QBLK*NW,KVBLK=64,NQB=SEQ/QB;
constexpr int ATTN_UNIT_ROWS=QB;
__device__ __forceinline__ int crow(int r,int hi){return (r&3)+8*(r>>2)+4*hi;}
#define SBAR() __builtin_amdgcn_sched_barrier(0)
__device__ __forceinline__ void cmask(f32x16&p0,f32x16&p1,int jb,int qrel,int hi){
  const float NEG=-INFINITY; int kb=64*jb+4*hi;
  #pragma unroll
  for(int r=0;r<16;++r){int kv=kb+(r&3)+8*(r>>2); if(kv>qrel)p0[r]=NEG; if(kv+32>qrel)p1[r]=NEG;}
}

constexpr int NSLOT=3, SLOTB=8192;
constexpr int LDS_K=0, LDS_V=NSLOT*SLOTB, LDS_WS=2*NSLOT*SLOTB, LDS_OST=LDS_WS+NW*64*4, LDS_BYTES=LDS_OST+NW*4096;
constexpr float C2=0.125f*1.4426950408889634f;
__device__ __forceinline__ void glds16(const void*gsrc,unsigned lds_dst){unsigned keep;
  asm volatile("s_mov_b32 %0, m0\n\ts_mov_b32 m0, %2\n\ts_nop 0\n\tglobal_load_lds_dwordx4 %1, off\n\ts_mov_b32 m0, %0":"=&s"(keep):"v"(gsrc),"s"(lds_dst):"memory");}
__device__ __forceinline__ float max3f(float a,float b,float c){float r;asm("v_max3_f32 %0, %1, %2, %3":"=v"(r):"v"(a),"v"(b),"v"(c));return r;}
__device__ __forceinline__ float max2f(float a,float b){float r;asm("v_max_f32_e32 %0, %1, %2":"=v"(r):"v"(a),"v"(b));return r;}
__device__ __forceinline__ float fadd_s(float a,float b){float r;asm("v_add_f32_e32 %0, %1, %2":"=v"(r):"v"(a),"v"(b));return r;}
__device__ __forceinline__ float fsub_s(float a,float b){float r;asm("v_sub_f32_e32 %0, %1, %2":"=v"(r):"v"(a),"v"(b));return r;}
typedef float f32x2_t __attribute__((ext_vector_type(2))); typedef __bf16 bf16x2_t __attribute__((ext_vector_type(2)));
__device__ __forceinline__ unsigned cvtpk_s(float lo,float hi){f32x2_t v={lo,hi};bf16x2_t b=__builtin_convertvector(v,bf16x2_t);return __builtin_bit_cast(unsigned,b);}
#define WAIT_BAR(N) asm volatile("s_waitcnt vmcnt(" #N ") lgkmcnt(0)\n\ts_barrier":::"memory")

__device__ __forceinline__ void qkt(f32x16&p0,f32x16&p1,const char*Kslot,const bf16x8*qr,const f32x16&negm,int r32,int hi){
  const char*kb=Kslot+hi*1024+r32*16;
  #pragma unroll
  for(int d0=0;d0<4;++d0){
    const bf16x8 b0=*reinterpret_cast<const bf16x8*>(kb+d0*2048);
    const bf16x8 b1=*reinterpret_cast<const bf16x8*>(kb+d0*2048+512);
    if(d0==0){p0=__builtin_amdgcn_mfma_f32_32x32x16_bf16(b0,qr[0],negm,0,0,0);p1=__builtin_amdgcn_mfma_f32_32x32x16_bf16(b1,qr[0],negm,0,0,0);}
    else{p0=__builtin_amdgcn_mfma_f32_32x32x16_bf16(b0,qr[d0],p0,0,0,0);p1=__builtin_amdgcn_mfma_f32_32x32x16_bf16(b1,qr[d0],p1,0,0,0);}}
}
typedef __attribute__((address_space(3))) const char* lds_cptr;
typedef short v4i16_t __attribute__((ext_vector_type(4)));
__device__ __forceinline__ void kload8(bf16x8*kf,lds_cptr kp){
  kf[0]=*(const __attribute__((address_space(3))) bf16x8*)(kp);      kf[1]=*(const __attribute__((address_space(3))) bf16x8*)(kp+512);
  kf[2]=*(const __attribute__((address_space(3))) bf16x8*)(kp+2048); kf[3]=*(const __attribute__((address_space(3))) bf16x8*)(kp+2560);
  kf[4]=*(const __attribute__((address_space(3))) bf16x8*)(kp+4096); kf[5]=*(const __attribute__((address_space(3))) bf16x8*)(kp+4608);
  kf[6]=*(const __attribute__((address_space(3))) bf16x8*)(kp+6144); kf[7]=*(const __attribute__((address_space(3))) bf16x8*)(kp+6656);
}
__device__ __forceinline__ void kload2(bf16x8*kf,lds_cptr kp,int j){ kf[2*j]=*(const __attribute__((address_space(3))) bf16x8*)(kp+j*2048); kf[2*j+1]=*(const __attribute__((address_space(3))) bf16x8*)(kp+j*2048+512); }
__device__ __forceinline__ s16x4 vtr(lds_cptr p){ return __builtin_bit_cast(s16x4,__builtin_amdgcn_ds_read_tr16_b64_v4i16((__attribute__((address_space(3))) v4i16_t*)p)); }
__device__ __forceinline__ float rowmax(const f32x16&p0,const f32x16&p1){
  float a=max3f(p0[0],p0[1],p1[0]),b=max3f(p0[2],p0[3],p1[1]);a=max3f(a,p1[2],p1[3]);
  #pragma unroll
  for(int r=4;r<16;r+=4){a=max3f(a,p0[r],p0[r+1]);b=max3f(b,p0[r+2],p0[r+3]);a=max3f(a,p1[r],p1[r+1]);b=max3f(b,p1[r+2],p1[r+3]);}
  const float m=max2f(a,b);
  auto rr=__builtin_amdgcn_permlane32_swap(__float_as_uint(m),__float_as_uint(m),false,false);
  return max2f(__uint_as_float(rr[0]),__uint_as_float(rr[1]));
}
__device__ __forceinline__ void pv(f32x16*o,int vb,bf16x8 pa0,bf16x8 pa1,bf16x8 pa2,bf16x8 pa3){
  #pragma unroll
  for(int d0=0;d0<2;++d0){s16x4 lo[4],hi[4];
    #pragma unroll
    for(int ks=0;ks<4;++ks){
      asm volatile("ds_read_b64_tr_b16 %0,%1 offset:%c2":"=&v"(lo[ks]):"v"(vb),"i"(d0*4096+ks*1024):"memory");
      asm volatile("ds_read_b64_tr_b16 %0,%1 offset:%c2":"=&v"(hi[ks]):"v"(vb),"i"(d0*4096+ks*1024+512):"memory");}
    asm volatile("s_waitcnt lgkmcnt(0)":::"memory");SBAR();
    #define PK(k) (bf16x8){lo[k][0],lo[k][1],lo[k][2],lo[k][3],hi[k][0],hi[k][1],hi[k][2],hi[k][3]}
    o[d0]=__builtin_amdgcn_mfma_f32_32x32x16_bf16(pa0,PK(0),o[d0],0,0,0);
    o[d0]=__builtin_amdgcn_mfma_f32_32x32x16_bf16(pa1,PK(1),o[d0],0,0,0);
    o[d0]=__builtin_amdgcn_mfma_f32_32x32x16_bf16(pa2,PK(2),o[d0],0,0,0);
    o[d0]=__builtin_amdgcn_mfma_f32_32x32x16_bf16(pa3,PK(3),o[d0],0,0,0);
    #undef PK
  }
}

#ifndef ATTN_STORE16
#define ATTN_STORE16(p,v) (*(u32x4*)(p)=(v))
#endif
template<int THRL> __device__ __forceinline__ void attn_unit(int b,int hv,int qb,const bf16*Q,const bf16*__restrict__ K,const bf16*__restrict__ V,bf16*O,char*shm){
  const int qkcol=(hv>>2)*128+((hv>>1)&1)*64, vcol=(hv>>2)*128+(hv&1)*64, ocol=((hv>>1)&1)*512+(hv>>2)*128+(hv&1)*64;
  int tid_=threadIdx.x; asm volatile("":"+v"(tid_)); int wid_=__builtin_amdgcn_readfirstlane(tid_>>6); asm volatile("":"+s"(wid_));
  const int tid=tid_,lane=tid&63,r32=lane&31,hi=lane>>5; const int wid=wid_;
  const long rowbase=(long)b*SEQ; const int q0=qb*QB;
  const bf16*Qw=Q+(rowbase+q0+wid*QBLK)*QKP+qkcol;
  const bf16*Kh=K+rowbase*QKP+qkcol,*Vh=V+rowbase*QKP+vcol;
  const unsigned lds0=(unsigned)(uintptr_t)shm;
  float*wsf=(float*)(shm+LDS_WS)+wid*64;
  const bf16*ksrc=Kh+(long)lane*QKP+wid*8;
  const bf16*vsrc=Vh+(long)(16*(wid&3)+(lane>>2))*QKP+(wid>>2)*32+(lane&3)*8;
  const unsigned kdst=lds0+LDS_K+wid*1024, vdst=lds0+LDS_V+wid*1024;
  #define DMA_K(t,slot) glds16(ksrc+(long)(t)*KVBLK*QKP,(unsigned)__builtin_amdgcn_readfirstlane(kdst+(slot)))
  #define DMA_V(t,slot) glds16(vsrc+(long)(t)*KVBLK*QKP,(unsigned)__builtin_amdgcn_readfirstlane(vdst+(slot)))
  const int vb0=(int)(lds0+LDS_V)+((lane>>4)&1)*32+(lane&3)*8+(4*hi+((lane&15)>>2))*64;
  const char*Kbase=shm+LDS_K; bf16x8 kf[8];
  const lds_cptr shm3=(lds_cptr)shm; const lds_cptr kp0=shm3+LDS_K+hi*1024+r32*16; const lds_cptr vp0=shm3+LDS_V+((lane>>4)&1)*32+(lane&3)*8+(4*hi+((lane&15)>>2))*64;
  const int NT=(q0+QB)/KVBLK;
  DMA_K(0,0);DMA_V(0,0);DMA_K(1,SLOTB);
  bf16x8 qr[4];
  #pragma unroll
  for(int d0=0;d0<4;++d0)qr[d0]=*reinterpret_cast<const bf16x8*>(&Qw[(long)r32*QKP+d0*16+hi*8]);
  float mhat=0.f,l_reg=0.f;f32x16 o[2];o[0]=f32x16{};o[1]=f32x16{};f32x16 negm=f32x16{};asm volatile("":"+v"(negm));
  const int qrel=wid*QBLK+r32;
  #define CMASK(P0,P1,t) do{int jb_=(t)-(NT-4); if(jb_>=0)cmask(P0,P1,jb_,qrel,hi);}while(0)
  bool resc=false;
  #define START(P0,P1) do{ const float rm=rowmax(P0,P1); resc=false; \
    { const float dl=rm; mhat=fadd_s(mhat,dl); \
      _Pragma("unroll") for(int r=0;r<16;++r){P0[r]=fsub_s(P0[r],dl);P1[r]=fsub_s(P1[r],dl);} \
      _Pragma("unroll") for(int r=0;r<16;++r)negm[r]=-mhat; asm volatile("":"+v"(negm)); } \
    _Pragma("unroll") for(int r=0;r<16;++r)P0[r]=__builtin_amdgcn_exp2f(P0[r]); }while(0)
  #define RESC() do{ if(resc){ asm volatile("s_waitcnt lgkmcnt(0)":::"memory"); \
      _Pragma("unroll") for(int d_=0;d_<2;++d_) _Pragma("unroll") for(int r=0;r<16;++r)o[d_][r]*=wsf[crow(r,hi)]; } }while(0)
  f32x16 pA0,pA1,pB0,pB1;
  int sl_prev=0,sl_cur=0,sl_next=SLOTB;
  #define ROT() do{sl_prev=sl_cur;sl_cur=sl_next;sl_next=(sl_next==(NSLOT-1)*SLOTB)?0:sl_next+SLOTB;}while(0)
  DMA_K(2,2*SLOTB);
  WAIT_BAR(3);
  qkt(pA0,pA1,Kbase,qr,negm,r32,hi);asm volatile("s_nop 15\n\ts_nop 7":"+v"(pA0),"+v"(pA1));CMASK(pA0,pA1,0);
  START(pA0,pA1);
  _Pragma("unroll") for(int r=0;r<16;++r)pA1[r]=__builtin_amdgcn_exp2f(pA1[r]);
  WAIT_BAR(0);
  DMA_K(3,0);DMA_V(1,SLOTB);
  ROT();
  kload8(kf,kp0+sl_cur);
  WAIT_BAR(2);
  s16x4 vlo[8],vhi[8]; u32x4 pw0,pw1,pw2,pw3;
  #define PKW(P,B) cvtpk_s(P[B],P[B+1])
  #define PAF(k) __builtin_bit_cast(bf16x8,pw##k)
  #define VFR(i) (bf16x8){vlo[i][0],vlo[i][1],vlo[i][2],vlo[i][3],vhi[i][0],vhi[i][1],vhi[i][2],vhi[i][3]}
  #define PIN(x) asm volatile("":"+v"(x))
  #define MX3(a,b,c) __builtin_fmaxf(__builtin_fmaxf((a),(b)),(c))
  #define GAPA(MF,A0,A1,A2,A3,W0,W1,PW) do{ MF; sacc+=A0; sacc+=A1; sacc+=A2; sacc+=A3; PIN(sacc); W0; W1; PIN(PW); SBAR(); }while(0)
  #define EX(v) __builtin_amdgcn_exp2f(v)
  #define GAPB(MF,X,B) do{ MF; X[B]=EX(X[B]); X[B+1]=EX(X[B+1]); X[B+2]=EX(X[B+2]); X[B+3]=EX(X[B+3]); PIN(X); SBAR(); }while(0)
  #define VRD(i) do{ vlo[i]=vtr(vp_+(((i)>>2)*4096+((i)&3)*1024)); vhi[i]=vtr(vp_+(((i)>>2)*4096+((i)&3)*1024+512)); }while(0)
  #define KRD(G,j) do{ if(G){ kload2(kf,kp0+sl_next,j); SBAR(); } }while(0)
  #define STEP(C0,C1,P0,P1,t,GK,GV,GL) do{ SBAR(); \
    const lds_cptr vp_=vp0+sl_prev; \
    VRD(0); SBAR(); float sacc=(P0[0]+P0[1]); \
    GAPA(C0=__builtin_amdgcn_mfma_f32_32x32x16_bf16(kf[0],qr[0],negm,0,0,0), P0[2],P0[3],P0[4],P0[5],     pw0[0]=PKW(P0,0), pw0[1]=PKW(P0,2), pw0); \
    VRD(4); SBAR(); GAPA(C1=__builtin_amdgcn_mfma_f32_32x32x16_bf16(kf[1],qr[0],negm,0,0,0), P0[6],P0[7],P0[8],P0[9],     pw0[2]=PKW(P0,4), pw0[3]=PKW(P0,6), pw0); \
    VRD(1); SBAR(); GAPA(C0=__builtin_amdgcn_mfma_f32_32x32x16_bf16(kf[2],qr[1],C0,0,0,0),   P0[10],P0[11],P0[12],P0[13], pw1[0]=PKW(P0,8), pw1[1]=PKW(P0,10), pw1); \
    VRD(5); SBAR(); GAPA(C1=__builtin_amdgcn_mfma_f32_32x32x16_bf16(kf[3],qr[1],C1,0,0,0),   P0[14],P0[15],P1[0],P1[1],   pw1[2]=PKW(P0,12),pw1[3]=PKW(P0,14), pw1); \
    VRD(2); SBAR(); GAPA(C0=__builtin_amdgcn_mfma_f32_32x32x16_bf16(kf[4],qr[2],C0,0,0,0),   P1[2],P1[3],P1[4],P1[5],     pw2[0]=PKW(P1,0), pw2[1]=PKW(P1,2), pw2); \
    VRD(6); SBAR(); GAPA(C1=__builtin_amdgcn_mfma_f32_32x32x16_bf16(kf[5],qr[2],C1,0,0,0),   P1[6],P1[7],P1[8],P1[9],     pw2[2]=PKW(P1,4), pw2[3]=PKW(P1,6), pw2); \
    VRD(3); SBAR(); GAPA(C0=__builtin_amdgcn_mfma_f32_32x32x16_bf16(kf[6],qr[3],C0,0,0,0),   P1[10],P1[11],P1[12],P1[13], pw3[0]=PKW(P1,8), pw3[1]=PKW(P1,10), pw3); \
    VRD(7); SBAR(); GAPA(C1=__builtin_amdgcn_mfma_f32_32x32x16_bf16(kf[7],qr[3],C1,0,0,0),   P1[14],P1[15],0.f,0.f,       pw3[2]=PKW(P1,12),pw3[3]=PKW(P1,14), pw3); \
    l_reg+=sacc; \
    if(GK){DMA_K((t)+3,sl_cur);} if(GV){DMA_V((t)+1,sl_next);} \
    CMASK(C0,C1,t); \
    { float a=MX3(C0[0],C0[1],C1[0]),b=MX3(C0[2],C0[3],C1[1]); a=MX3(a,C1[2],C1[3]); \
      _Pragma("unroll") for(int r=4;r<16;r+=4){a=MX3(a,C0[r],C0[r+1]);b=MX3(b,C0[r+2],C0[r+3]);a=MX3(a,C1[r],C1[r+1]);b=MX3(b,C1[r+2],C1[r+3]);} \
      float rm=__builtin_fmaxf(a,b); { auto rr=__builtin_amdgcn_permlane32_swap(__float_as_uint(rm),__float_as_uint(rm),false,false); rm=__builtin_fmaxf(__uint_as_float(rr[0]),__uint_as_float(rr[1])); } \
      resc=false; \
      if(__builtin_expect(__any(rm>(float)THRL),0)){ const float dl=__builtin_fmaxf(rm,0.f); mhat+=dl; \
        _Pragma("unroll") for(int r=0;r<16;++r){C0[r]-=dl;C1[r]-=dl;} \
        _Pragma("unroll") for(int r=0;r<16;++r)negm[r]=-mhat; asm volatile("":"+v"(negm)); \
        const float f=__builtin_amdgcn_exp2f(-dl); l_reg*=f; if(hi==0)wsf[r32]=f; resc=true; } } \
    SBAR(); \
    GAPB(o[0]=__builtin_amdgcn_mfma_f32_32x32x16_bf16(PAF(0),VFR(0),o[0],0,0,0), C0,0); \
    GAPB(o[1]=__builtin_amdgcn_mfma_f32_32x32x16_bf16(PAF(0),VFR(4),o[1],0,0,0), C0,4); \
    KRD(GL,0); GAPB(o[0]=__builtin_amdgcn_mfma_f32_32x32x16_bf16(PAF(1),VFR(1),o[0],0,0,0), C0,8); \
    KRD(GL,1); GAPB(o[1]=__builtin_amdgcn_mfma_f32_32x32x16_bf16(PAF(1),VFR(5),o[1],0,0,0), C0,12); \
    KRD(GL,2); GAPB(o[0]=__builtin_amdgcn_mfma_f32_32x32x16_bf16(PAF(2),VFR(2),o[0],0,0,0), C1,0); \
    KRD(GL,3); GAPB(o[1]=__builtin_amdgcn_mfma_f32_32x32x16_bf16(PAF(2),VFR(6),o[1],0,0,0), C1,4); \
    GAPB(o[0]=__builtin_amdgcn_mfma_f32_32x32x16_bf16(PAF(3),VFR(3),o[0],0,0,0), C1,8); \
    GAPB(o[1]=__builtin_amdgcn_mfma_f32_32x32x16_bf16(PAF(3),VFR(7),o[1],0,0,0), C1,12); \
    }while(0)
  int t=1;
  #undef CMASK
  #define CMASK(P0,P1,t) do{}while(0)
  for(;t+5<NT;t+=2){
    STEP(pB0,pB1,pA0,pA1,t,true,true,true);     WAIT_BAR(2); RESC(); ROT();
    STEP(pA0,pA1,pB0,pB1,t+1,true,true,true);   WAIT_BAR(2); RESC(); ROT();
  }
  #undef CMASK
  #define CMASK(P0,P1,t) do{int jb_=(t)-(NT-4); if(jb_>=0)cmask(P0,P1,jb_,qrel,hi);}while(0)
  #define ENDW(tt) do{ if((tt)+3<NT){WAIT_BAR(2);} else if((tt)+2<NT){WAIT_BAR(1);} else {WAIT_BAR(0);} }while(0)
  for(;t+1<NT;t+=2){
    STEP(pB0,pB1,pA0,pA1,t,(t+3<NT),(t+1<NT),(t+1<NT));       ENDW(t);   RESC(); ROT();
    STEP(pA0,pA1,pB0,pB1,t+1,(t+4<NT),(t+2<NT),(t+2<NT));     ENDW(t+1); RESC(); ROT();
  }
  STEP(pB0,pB1,pA0,pA1,NT-1,false,false,false); RESC();
  { float sacc=pB0[0]+pB0[1]; _Pragma("unroll") for(int r=2;r<16;++r)sacc+=pB0[r]; _Pragma("unroll") for(int r=0;r<16;++r)sacc+=pB1[r]; l_reg+=sacc;
    pw0=(u32x4){PKW(pB0,0),PKW(pB0,2),PKW(pB0,4),PKW(pB0,6)};pw1=(u32x4){PKW(pB0,8),PKW(pB0,10),PKW(pB0,12),PKW(pB0,14)};pw2=(u32x4){PKW(pB1,0),PKW(pB1,2),PKW(pB1,4),PKW(pB1,6)};pw3=(u32x4){PKW(pB1,8),PKW(pB1,10),PKW(pB1,12),PKW(pB1,14)};
    SBAR(); pv(o,vb0+sl_cur,PAF(0),PAF(1),PAF(2),PAF(3)); }
  #undef PKW
  #undef PAF
  #undef VFR
  #undef PIN
  #undef MX3
  #undef GAPA
  #undef GAPB
  #undef EX
  #undef VRD
  #undef KRD
  #undef STEP
  #undef ENDW
  {auto rr=__builtin_amdgcn_permlane32_swap(__float_as_uint(l_reg),__float_as_uint(l_reg),false,false);l_reg=__uint_as_float(rr[0])+__uint_as_float(rr[1]);}
  if(hi==0)wsf[32+r32]=l_reg;asm volatile("s_waitcnt lgkmcnt(0)":::"memory");
  float rli[16];
  #pragma unroll
  for(int r=0;r<16;++r)rli[r]=__builtin_amdgcn_rcpf(wsf[32+crow(r,hi)]);
  bf16*Ow=O+(rowbase+q0+wid*QBLK)*OP+ocol;
  { bf16*stg=(bf16*)(shm+LDS_OST)+wid*2048;
    #pragma unroll
    for(int r=0;r<16;++r){const int orow=crow(r,hi);
      #pragma unroll
      for(int d0=0;d0<2;++d0)stg[orow*64+d0*32+r32]=__float2bfloat16(o[d0][r]*rli[r]);}
    asm volatile("s_waitcnt lgkmcnt(0)":::"memory");
    #pragma unroll
    for(int i=0;i<4;++i){const int row=i*8+(lane>>3),ch=lane&7; const u32x4 v=*(const u32x4*)(stg+row*64+ch*8); ATTN_STORE16(Ow+(long)row*OP+ch*8,v);} }
  asm volatile("s_waitcnt lgkmcnt(0)\n\ts_barrier":::"memory");
  #undef DMA_K
  #undef DMA_V
  #undef CMASK
  #undef START
  #undef RESC
  #undef ROT
}
constexpr int ATTN_LDS_BYTES=LDS_BYTES;
struct AttnTensors { const bf16* Q; const bf16* K; const bf16* V; bf16* O; };
struct AttnUnit { int bh; int qb; };
struct StaticOrder {
  int vcu;
  __device__ __forceinline__ explicit StaticOrder(int grid,int block):vcu((block%8)*(grid/8)+block/8){}
  __device__ __forceinline__ bool next(int i,AttnUnit&u)const{ if(i>=4)return false; const int s=vcu&7; u.bh=vcu>>3; u.qb=(i==0)?s:(i==1)?15-s:(i==2)?16+s:31-s; return true; }
  __device__ __forceinline__ void a_ready(const AttnUnit&)const{}
  __device__ __forceinline__ void done(const AttnUnit&)const{}
};
template<class Sched,int THRL=8> __device__ __forceinline__ void attn_phase(char*lds,const AttnTensors&T,const Sched&S){
  AttnUnit u;
  for(int i=0;S.next(i,u);++i){ S.a_ready(u); attn_unit<THRL>(u.bh/NHEAD,u.bh%NHEAD,u.qb,T.Q,T.K,T.V,T.O,lds); S.done(u); }
}
#undef SBAR
#undef WAIT_BAR
}
#define GAS __attribute__((address_space(1)))
#define LAS __attribute__((address_space(3)))
typedef unsigned short bf16;
typedef unsigned v4u __attribute__((ext_vector_type(4)));
typedef float f32x4 __attribute__((ext_vector_type(4)));
typedef short bf16x8 __attribute__((ext_vector_type(8)));
typedef GAS unsigned gu32;
typedef GAS unsigned long long gu64;
#define RLX_AGENT __ATOMIC_RELAXED, __HIP_MEMORY_SCOPE_AGENT
#define LDS_WAIT() asm volatile("s_waitcnt lgkmcnt(0)" ::: "memory")
#define VM_WAIT() asm volatile("s_waitcnt vmcnt(0)" ::: "memory")
__device__ __forceinline__ unsigned long long rt() { return __builtin_amdgcn_s_memrealtime(); }
__device__ __forceinline__ unsigned f2bf(float f) { unsigned u = __builtin_bit_cast(unsigned, f); return (u + 0x7fffu + ((u >> 16) & 1u)) >> 16; }
__device__ __forceinline__ unsigned pk2(float lo, float hi) { return f2bf(lo) | (f2bf(hi) << 16); }

#define XB_TMO      128
#define XB_XCNT(j)  (256  + 64 * (j))
#define XB_XSUB(j)  (1280 + 64 * (j))
#define XB_XGEN(j)  (2304 + 64 * (j))
#define XB_TOP      3328
#define XB_TOPGEN   3392
#define XCD_BAR_WORDS 3456
#define XB_SPIN_CAP (1u << 18)

__device__ __forceinline__ unsigned xb_ld(unsigned* p)              { return __hip_atomic_load(p, __ATOMIC_RELAXED, __HIP_MEMORY_SCOPE_AGENT); }
__device__ __forceinline__ unsigned xb_add(unsigned* p, unsigned v) { return __hip_atomic_fetch_add(p, v, __ATOMIC_RELAXED, __HIP_MEMORY_SCOPE_AGENT); }
__device__ __forceinline__ unsigned xb_xcc_id() { return (unsigned)__builtin_amdgcn_s_getreg((3 << 11) | 20) & 0xFu; }
#define XB_SPIN(cond, bar) do { unsigned _sp = 0; while (cond) { __builtin_amdgcn_s_sleep(1); \
    if ((++_sp & 255u) == 0u) { if (xb_ld(&(bar)[XB_TMO])) break; if (_sp > XB_SPIN_CAP) { atomicAdd(&(bar)[XB_TMO], 1u); break; } } } } while (0)

struct XcdBarrier {
    unsigned* bar; unsigned x;
    volatile LAS unsigned* st;
};

__device__ __forceinline__ XcdBarrier xcd_barrier_post(unsigned* bar, volatile LAS unsigned* st) {
    XcdBarrier b; b.bar = bar; b.x = xb_xcc_id(); b.st = st;
    if (threadIdx.x == 0) (void)xb_add(&bar[XB_XCNT(b.x)], 1u);
    return b;
}
__device__ __forceinline__ void xcd_barrier_complete(unsigned* bar, unsigned x, unsigned& nloc, unsigned& nx) {
    const unsigned G = gridDim.x * gridDim.y * gridDim.z;
    unsigned sum, cnt, mine, sp = 0u;
    for (;;) {
        sum = 0u; cnt = 0u; mine = 0u;
#pragma unroll
        for (unsigned j = 0; j < 16; ++j) { const unsigned c = xb_ld(&bar[XB_XCNT(j)]); sum += c; cnt += (c > 0u) ? 1u : 0u; mine = (j == x) ? c : mine; }
        if (sum == G) break;
        __builtin_amdgcn_s_sleep(1);
        if ((++sp & 255u) == 0u) { if (xb_ld(&bar[XB_TMO])) break; if (sp > XB_SPIN_CAP) { atomicAdd(&bar[XB_TMO], 1u); break; } }
    }
    nloc = mine > 0u ? mine : 1u; nx = cnt > 0u ? cnt : 1u;
}

__device__ __forceinline__ void xcd_barrier(const XcdBarrier& b) {
    asm volatile("s_waitcnt vmcnt(0)" ::: "memory");
    __syncthreads();
    if (threadIdx.x == 0) {
        unsigned* bar = b.bar;
        __builtin_amdgcn_s_waitcnt(0);
        unsigned nloc = b.st[0], nx = b.st[1];
        if (nloc == 0u) { xcd_barrier_complete(bar, b.x, nloc, nx); b.st[0] = nloc; b.st[1] = nx; }
        const unsigned old = xb_add(&bar[XB_XSUB(b.x)], 1u);
        const unsigned gen = old / nloc;
        if (old + 1u == (gen + 1u) * nloc) {
            __builtin_amdgcn_fence(__ATOMIC_RELEASE, "agent");
            asm volatile("s_waitcnt vmcnt(0)" ::: "memory");
            const unsigned og = xb_add(&bar[XB_TOP], 1u);
            const unsigned tg = og / nx;
            if (og + 1u == (tg + 1u) * nx) xb_add(&bar[XB_TOPGEN], 1u);
            else XB_SPIN(xb_ld(&bar[XB_TOPGEN]) == tg, bar);
            __builtin_amdgcn_fence(__ATOMIC_ACQUIRE, "agent");
            xb_add(&bar[XB_XGEN(b.x)], 1u);
            asm volatile("s_waitcnt vmcnt(0)" ::: "memory");
        } else {
            XB_SPIN(xb_ld(&bar[XB_XGEN(b.x)]) == gen, bar);
            __builtin_amdgcn_fence(__ATOMIC_ACQUIRE, "agent");
            asm volatile("s_waitcnt vmcnt(0)" ::: "memory");
        }
    }
    __syncthreads();
}

constexpr int NWAVES = 8;
constexpr int BATCH = 2, SEQ = 8192, DMODEL = 1024, DEPTH = 2, NMEM = 256, DFF = 2816, DIN = 2560;
constexpr int M = BATCH * SEQ;
constexpr float C2_DIFF = 0.125f * 1.4426950408889634f;
constexpr float C2_CROSS = 0.0625f * 1.4426950408889634f;
constexpr size_t MiB = 1u << 20;
constexpr size_t WS_CTL = 0, CTL_ZERO_BYTES = 64 * 1024;
constexpr size_t WS_STATS = 1 * MiB;
constexpr size_t WS_CS = 2 * MiB;
constexpr size_t WS_MEMN = 3 * MiB;
constexpr size_t WS_KC = 4 * MiB;
constexpr size_t WS_VCT = 6 * MiB;
constexpr size_t WS_W = 8 * MiB;
constexpr size_t W_GU = (size_t)2 * DFF * DMODEL * 2, W_D = (size_t)DMODEL * DFF * 2, W_IN = (size_t)DIN * DMODEL * 2, W_SQ = (size_t)DMODEL * DMODEL * 2;
constexpr size_t WO_GU1 = 0, WO_D1 = WO_GU1 + W_GU, WO_IN = WO_D1 + W_D, WO_OUT = WO_IN + W_IN, WO_Q = WO_OUT + W_SQ, WO_O = WO_Q + W_SQ, WO_GU2 = WO_O + W_SQ, WO_D2 = WO_GU2 + W_GU, W_LAYER = WO_D2 + W_D;
constexpr size_t WS_WKV = WS_W + 2 * W_LAYER;
constexpr size_t WS_HB = 104 * MiB;
constexpr size_t WS_R1 = 136 * MiB;
constexpr size_t R1_HMID = 0;
constexpr size_t R1_Q = 0, R1_T = 16 * MiB;
constexpr size_t R1_O12 = 80 * MiB;
constexpr size_t R1_AG = 0;
constexpr size_t R1_QC = 0, R1_P = 32 * MiB, R1_OC = 64 * MiB;
constexpr size_t WS_END = 248 * MiB;
static_assert(W_LAYER == 44 * MiB && WS_WKV + (size_t)2 * 2048 * 1024 * 2 == WS_HB && WS_HB + (size_t)M * 1024 * 2 == WS_R1 && WS_R1 + 112 * MiB == WS_END, "d_ws map");
constexpr int CW_BAR = 4096;
constexpr int RING_OFF = 0, RING_BYTES = 131072;
constexpr int LDSCTL_OFF = RING_BYTES, MISC_OFF = LDSCTL_OFF + 320;
constexpr int LDS_BYTES = 147456;
static_assert(MISC_OFF + 128 <= LDS_BYTES, "LDS map");
static_assert((CW_BAR + 3456) * 4 <= (int)CTL_ZERO_BYTES, "CTL words inside the memset region");

struct Args { const float* in[27]; float* out; unsigned char* ws; };
typedef const __attribute__((address_space(4))) Args* KArgs;
#define AS1(T, p) ((T*)(__attribute__((address_space(1))) T*)(p))
#define INP(a, i) AS1(const float, (a).in[i])
#define OUTP(a) AS1(float, (a).out)
#define WSP(a) AS1(unsigned char, (a).ws)

__device__ __forceinline__ float wave_sum(float v) {
#pragma unroll
    for (int o = 1; o < 64; o <<= 1) v += __shfl_xor(v, o);
    return v;
}
__device__ __forceinline__ void p0_transpose_item(const float* W, int K, int N, bf16* WT, const float* gain, bool swiglu, LAS float* scr, int item, int lane) {
    const int nblk = N / 32, kb = item / nblk, nb = item % nblk, k0 = 64 * kb, n0 = 32 * nb;
#pragma unroll 8
    for (int i = 0; i < 32; ++i) { const int kk = 2 * i + (lane >> 5); const float gn = gain ? gain[k0 + kk] : 1.0f; scr[kk * 33 + (lane & 31)] = W[(size_t)(k0 + kk) * N + n0 + (lane & 31)] * gn; }
    LDS_WAIT(); asm volatile("" ::: "memory");
    int d0 = n0; if (swiglu) { const int half = N >> 1, up = (n0 >= half) ? 1 : 0, j = n0 - up * half; d0 = 256 * (j >> 7) + 128 * up + (j & 127); }
    const int c = lane & 7;
#pragma unroll
    for (int j = 0; j < 4; ++j) { const int n = (lane >> 3) + 8 * j; const LAS float* s = scr + (8 * c) * 33 + n;
        v4u o; o.x = pk2(s[0 * 33], s[1 * 33]); o.y = pk2(s[2 * 33], s[3 * 33]); o.z = pk2(s[4 * 33], s[5 * 33]); o.w = pk2(s[6 * 33], s[7 * 33]);
        *(GAS v4u*)(WT + (size_t)(d0 + n) * K + k0 + 8 * c) = o; }
    LDS_WAIT(); asm volatile("" ::: "memory");
}
__device__ __forceinline__ void sincos_d(float af, float& sn, float& cs) {
    const double a = (double)af; const double kq = __builtin_rint(a * 0.6366197723675814); const double r = __builtin_fma(-kq, 1.5707963267948966, a) - kq * 6.123233995736766e-17;
    const double r2 = r * r;
    const double sp = r * (1.0 + r2 * (-1.0 / 6 + r2 * (1.0 / 120 + r2 * (-1.0 / 5040 + r2 * (1.0 / 362880 + r2 * (-1.0 / 39916800 + r2 * (1.0 / 6227020800.0)))))));
    const double cp = 1.0 + r2 * (-0.5 + r2 * (1.0 / 24 + r2 * (-1.0 / 720 + r2 * (1.0 / 40320 + r2 * (-1.0 / 3628800 + r2 * (1.0 / 479001600 + r2 * (-1.0 / 87178291200.0)))))));
    const int q = ((int)(long long)kq) & 3;
    const double s_ = (q & 1) ? cp : sp, c_ = (q & 1) ? sp : cp;
    sn = (float)((q & 2) ? -s_ : s_); cs = (float)(((q == 1) || (q == 2)) ? -c_ : c_);
}

struct Frame { LAS unsigned char* lds; int tid, lane, wave, vcu, G; };

__device__ __forceinline__ void p0_prologue(KArgs ap, const Frame& F) {
#define a (*ap)
    LAS float* scr = (LAS float*)(F.lds + RING_OFF + F.wave * 16384);
    const int gw = F.vcu * NWAVES + F.wave, NGW = F.G * NWAVES;
    unsigned char* ws = WSP(a);
    constexpr int I_GU = 16 * 176, I_D = 44 * 32, I_IN = 16 * 80, I_SQ = 16 * 32, I_KV = 16 * 64, I_LAYER = 2 * I_GU + 2 * I_D + I_IN + 3 * I_SQ + I_KV;
    for (int it = gw; it < DEPTH * I_LAYER; it += NGW) {
        const int l = it / I_LAYER; int r = it % I_LAYER;
        bf16* wl = (bf16*)(ws + WS_W + (size_t)l * W_LAYER);
        if (r < I_GU) { p0_transpose_item(INP(a, 4) + (size_t)l * DMODEL * 2 * DFF, DMODEL, 2 * DFF, (bf16*)((unsigned char*)wl + WO_GU1), INP(a, 3) + l * DMODEL, true, scr, r, F.lane); continue; } r -= I_GU;
        if (r < I_D) { p0_transpose_item(INP(a, 5) + (size_t)l * DFF * DMODEL, DFF, DMODEL, (bf16*)((unsigned char*)wl + WO_D1), nullptr, false, scr, r, F.lane); continue; } r -= I_D;
        if (r < I_IN) { p0_transpose_item(INP(a, 7) + (size_t)l * DMODEL * DIN, DMODEL, DIN, (bf16*)((unsigned char*)wl + WO_IN), INP(a, 6) + l * DMODEL, false, scr, r, F.lane); continue; } r -= I_IN;
        if (r < I_SQ) { p0_transpose_item(INP(a, 17) + (size_t)l * DMODEL * DMODEL, DMODEL, DMODEL, (bf16*)((unsigned char*)wl + WO_OUT), nullptr, false, scr, r, F.lane); continue; } r -= I_SQ;
        if (r < I_SQ) { p0_transpose_item(INP(a, 20) + (size_t)l * DMODEL * DMODEL, DMODEL, DMODEL, (bf16*)((unsigned char*)wl + WO_Q), INP(a, 18) + l * DMODEL, false, scr, r, F.lane); continue; } r -= I_SQ;
        if (r < I_KV) { p0_transpose_item(INP(a, 21) + (size_t)l * DMODEL * 2 * DMODEL, DMODEL, 2 * DMODEL, (bf16*)(ws + WS_WKV) + (size_t)l * 2048 * 1024, INP(a, 19) + l * DMODEL, false, scr, r, F.lane); continue; } r -= I_KV;
        if (r < I_SQ) { p0_transpose_item(INP(a, 22) + (size_t)l * DMODEL * DMODEL, DMODEL, DMODEL, (bf16*)((unsigned char*)wl + WO_O), nullptr, false, scr, r, F.lane); continue; } r -= I_SQ;
        if (r < I_GU) { p0_transpose_item(INP(a, 24) + (size_t)l * DMODEL * 2 * DFF, DMODEL, 2 * DFF, (bf16*)((unsigned char*)wl + WO_GU2), INP(a, 23) + l * DMODEL, true, scr, r, F.lane); continue; } r -= I_GU;
        p0_transpose_item(INP(a, 25) + (size_t)l * DFF * DMODEL, DFF, DMODEL, (bf16*)((unsigned char*)wl + WO_D2), nullptr, false, scr, r, F.lane);
    }
    { const float* x = INP(a, 0); bf16* hb = (bf16*)(ws + WS_HB); float* stats = (float*)(ws + WS_STATS);
      for (int m = gw; m < M; m += NGW) { const GAS f32x4* xr = (const GAS f32x4*)(x + (size_t)m * DMODEL) + F.lane; f32x4 v[4]; float s = 0.f;
#pragma unroll
          for (int j = 0; j < 4; ++j) { v[j] = xr[64 * j]; s += (v[j].x * v[j].x + v[j].y * v[j].y) + (v[j].z * v[j].z + v[j].w * v[j].w); }
          s = wave_sum(s);
          GAS unsigned long long* o8 = (GAS unsigned long long*)(hb + (size_t)m * DMODEL) + F.lane;
#pragma unroll
          for (int j = 0; j < 4; ++j) o8[64 * j] = (unsigned long long)pk2(v[j].x, v[j].y) | ((unsigned long long)pk2(v[j].z, v[j].w) << 32);
          if (F.lane == 0) *(GAS f32x4*)(stats + (size_t)m * 4) = (f32x4){s, 0.f, 0.f, 0.f}; } }
    { const float* mem = INP(a, 1); bf16* mn = (bf16*)(ws + WS_MEMN);
      for (int m = gw; m < BATCH * NMEM; m += NGW) { const GAS f32x4* xr = (const GAS f32x4*)(mem + (size_t)m * DMODEL) + F.lane; f32x4 v[4]; float s = 0.f;
#pragma unroll
          for (int j = 0; j < 4; ++j) { v[j] = xr[64 * j]; s += (v[j].x * v[j].x + v[j].y * v[j].y) + (v[j].z * v[j].z + v[j].w * v[j].w); }
          const float r = 1.0f / sqrtf(wave_sum(s) * (1.0f / DMODEL) + 1e-6f);
          GAS unsigned long long* o8 = (GAS unsigned long long*)(mn + (size_t)m * DMODEL) + F.lane;
#pragma unroll
          for (int j = 0; j < 4; ++j) o8[64 * j] = (unsigned long long)pk2(v[j].x * r, v[j].y * r) | ((unsigned long long)pk2(v[j].z * r, v[j].w * r) << 32); } }
    { const int* pos = AS1(const int, (const int*)(a).in[2]); float* cs = (float*)(ws + WS_CS);
      const float invf[8] = {1.0f, 0.193922758102417f, 0.03760603070259094f, 0.00729266507551074f, 0.001414213445968926f, 0.00027424818836152554f, 5.318296462064609e-05f, 1.0313385246263351e-05f};
      for (int idx = gw * 64 + F.lane; idx < M * 8; idx += NGW * 64) { const int row = idx >> 3, j = idx & 7;
          float iv = invf[0];
#pragma unroll
          for (int q = 1; q < 8; ++q) iv = (j == q) ? invf[q] : iv;
          const float ang = (float)pos[row] * iv; float sn, c; sincos_d(ang, sn, c); cs[(size_t)row * 16 + j] = c; cs[(size_t)row * 16 + 8 + j] = sn; } }
}

#undef a
__device__ __forceinline__ void gmlp_unit(int cn, int g, const bf16* gu, const bf16* gv, const float* Wl, const float* bsl, const float* lng, const float* lnb, bf16* AG, LAS unsigned char* lds, int wave, int lane) {
    constexpr int VP = 136;
    LAS bf16* vnT = (LAS bf16*)lds;
    { const int tl = 16 * wave + (lane >> 2), c0 = (lane & 3) * 32; const size_t grow = (size_t)cn * 128 + tl;
      const GAS v4u* src = (const GAS v4u*)(gv + grow * 512 + g * 128 + c0);
      float v[32];
#pragma unroll
      for (int q = 0; q < 4; ++q) { const v4u w = src[q];
#pragma unroll
          for (int e = 0; e < 4; ++e) { const unsigned ww = w[e]; v[q * 8 + 2 * e] = __uint_as_float(ww << 16); v[q * 8 + 2 * e + 1] = __uint_as_float(ww & 0xffff0000u); } }
      float s = 0.f;
#pragma unroll
      for (int i = 0; i < 32; ++i) s += v[i];
      s += __shfl_xor(s, 1); s += __shfl_xor(s, 2);
      const float mean = s * (1.0f / 128.0f); float q2 = 0.f;
#pragma unroll
      for (int i = 0; i < 32; ++i) { v[i] -= mean; q2 += v[i] * v[i]; }
      q2 += __shfl_xor(q2, 1); q2 += __shfl_xor(q2, 2);
      const float rstd = 1.0f / sqrtf(q2 * (1.0f / 128.0f) + 1e-6f);
#pragma unroll
      for (int i = 0; i < 32; ++i) { const int c = c0 + i; const float y = v[i] * rstd * lng[g * 128 + c] + lnb[g * 128 + c]; vnT[c * VP + tl] = (bf16)f2bf(y); } }
    LDS_WAIT(); __syncthreads();
    const int t0 = 16 * wave, fr = lane & 15, fq = lane >> 4;
    f32x4 acc[8];
#pragma unroll
    for (int nb = 0; nb < 8; ++nb) acc[nb] = (f32x4){0.f, 0.f, 0.f, 0.f};
    const int nks = (t0 + 15) / 32 + 1;
    for (int ks = 0; ks < nks; ++ks) {
        const int t = t0 + fr, s0 = 32 * ks + 8 * fq;
        const float* wp = Wl + ((size_t)g * 128 + t) * 128 + s0;
        const f32x4 w0 = *(const GAS f32x4*)wp, w1 = *(const GAS f32x4*)(wp + 4);
        float wv[8] = {w0.x, w0.y, w0.z, w0.w, w1.x, w1.y, w1.z, w1.w};
#pragma unroll
        for (int j = 0; j < 8; ++j) wv[j] = (s0 + j <= t) ? wv[j] : 0.f;
        v4u wf; wf.x = pk2(wv[0], wv[1]); wf.y = pk2(wv[2], wv[3]); wf.z = pk2(wv[4], wv[5]); wf.w = pk2(wv[6], wv[7]);
        const bf16x8 wfrag = __builtin_bit_cast(bf16x8, wf);
#pragma unroll
        for (int nb = 0; nb < 8; ++nb) { const bf16x8 vf = *(const LAS bf16x8*)(vnT + (16 * nb + fr) * VP + s0);
            acc[nb] = __builtin_amdgcn_mfma_f32_16x16x32_bf16(vf, wfrag, acc[nb], 0, 0, 0); }
    }
    { const int t = t0 + fr; const size_t row = (size_t)cn * 128 + t; const float bt = bsl[g * 128 + t];
#pragma unroll
      for (int nb = 0; nb < 8; ++nb) { const int c = 16 * nb + 4 * fq; const unsigned long long gw8 = *(const GAS unsigned long long*)(gu + row * 512 + g * 128 + c);
          const unsigned lo = (unsigned)gw8, hi = (unsigned)(gw8 >> 32);
          const float g0 = __uint_as_float(lo << 16), g1 = __uint_as_float(lo & 0xffff0000u), g2 = __uint_as_float(hi << 16), g3 = __uint_as_float(hi & 0xffff0000u);
          const unsigned long long o = (unsigned long long)pk2(g0 * (acc[nb][0] + bt), g1 * (acc[nb][1] + bt)) | ((unsigned long long)pk2(g2 * (acc[nb][2] + bt), g3 * (acc[nb][3] + bt)) << 32);
          *(GAS unsigned long long*)(AG + row * 1024 + 512 + g * 128 + c) = o; } }
    LDS_WAIT(); __syncthreads();
}
__device__ __forceinline__ void mix2_phase(KArgs ap, const Frame& F, int l) {
#define a (*ap)
    unsigned char* ws = WSP(a);
    const bf16* gu = (const bf16*)(ws + WS_R1 + R1_Q + 3 * R1_T); const bf16* gv = (const bf16*)(ws + WS_R1 + R1_Q + 4 * R1_T);
    const bf16* O12 = (const bf16*)(ws + WS_R1 + R1_O12); bf16* AG = (bf16*)(ws + WS_R1 + R1_AG);
    for (int i = 0; i < 2; ++i) { const int u = F.vcu * 2 + i; if (u < 512) gmlp_unit(u >> 2, u & 3, gu, gv, INP(a, 15) + (size_t)l * 4 * 128 * 128, INP(a, 16) + l * 512, INP(a, 13) + l * 512, INP(a, 14) + l * 512, AG, F.lds + RING_OFF, F.wave, F.lane); }
    const float li = (l == 0) ? 0.2f : 0.35550906759096934f;
    const float s1 = wave_sum(INP(a, 8)[l * 64 + F.lane] * INP(a, 9)[l * 64 + F.lane]), s2 = wave_sum(INP(a, 10)[l * 64 + F.lane] * INP(a, 11)[l * 64 + F.lane]);
    const float lam = __expf(s1) - __expf(s2) + li;
    const float* sub = INP(a, 12) + l * 128 + (F.lane & 15) * 8; float sg[8];
#pragma unroll
    for (int e = 0; e < 8; ++e) sg[e] = sub[e] * (1.0f - li);
    const int gw = F.vcu * NWAVES + F.wave, NGW = F.G * NWAVES;
    for (int m = gw; m < M; m += NGW) {
        const v4u w1 = *(const GAS v4u*)(O12 + (size_t)m * 1024 + F.lane * 8), w2 = *(const GAS v4u*)(O12 + (size_t)m * 1024 + 512 + F.lane * 8);
        float d[8]; float ss = 0.f;
#pragma unroll
        for (int e = 0; e < 4; ++e) { const float a0 = __uint_as_float(w1[e] << 16), a1 = __uint_as_float(w1[e] & 0xffff0000u), b0 = __uint_as_float(w2[e] << 16), b1 = __uint_as_float(w2[e] & 0xffff0000u);
            d[2 * e] = a0 - lam * b0; d[2 * e + 1] = a1 - lam * b1; ss += d[2 * e] * d[2 * e] + d[2 * e + 1] * d[2 * e + 1]; }
        ss += __shfl_xor(ss, 1); ss += __shfl_xor(ss, 2); ss += __shfl_xor(ss, 4); ss += __shfl_xor(ss, 8);
        const float r = 1.0f / sqrtf(ss * (1.0f / 128.0f) + 1e-6f);
        v4u o; o.x = pk2(d[0] * r * sg[0], d[1] * r * sg[1]); o.y = pk2(d[2] * r * sg[2], d[3] * r * sg[3]); o.z = pk2(d[4] * r * sg[4], d[5] * r * sg[5]); o.w = pk2(d[6] * r * sg[6], d[7] * r * sg[7]);
        *(GAS v4u*)(AG + (size_t)m * 1024 + F.lane * 8) = o;
    }
}
#undef a
__device__ __forceinline__ void final_norm_phase(KArgs ap, const Frame& F) {
#define a (*ap)
    const float* gn = INP(a, 26); float* out = OUTP(a);
    const int gw = F.vcu * NWAVES + F.wave, NGW = F.G * NWAVES;
    f32x4 g4[4];
#pragma unroll
    for (int j = 0; j < 4; ++j) g4[j] = *(const GAS f32x4*)(gn + 4 * F.lane + 256 * j);
    for (int m = gw; m < M; m += NGW) { GAS f32x4* xr = (GAS f32x4*)(out + (size_t)m * DMODEL) + F.lane; f32x4 v[4]; float s = 0.f;
#pragma unroll
        for (int j = 0; j < 4; ++j) { v[j] = xr[64 * j]; s += (v[j].x * v[j].x + v[j].y * v[j].y) + (v[j].z * v[j].z + v[j].w * v[j].w); }
        const float r = 1.0f / sqrtf(wave_sum(s) * (1.0f / DMODEL) + 1e-6f);
#pragma unroll
        for (int j = 0; j < 4; ++j) xr[64 * j] = v[j] * r * g4[j]; }
}

#undef a
#define KA() ({ KArgs p_ = (KArgs)__builtin_amdgcn_kernarg_segment_ptr(); asm volatile("" : "+s"(p_)); p_; })
__device__ __forceinline__ Frame make_frame(LAS unsigned char* l) {
    Frame F; F.lds = l; int t_ = threadIdx.x; asm volatile("" : "+v"(t_)); F.tid = t_; F.lane = F.tid & 63; int w_ = __builtin_amdgcn_readfirstlane(F.tid >> 6); asm volatile("" : "+s"(w_)); F.wave = w_;
    F.G = gridDim.x; { const int bx = blockIdx.x; F.vcu = (F.G % 8 == 0) ? (bx % 8) * (F.G / 8) + bx / 8 : bx; } return F;
}
__global__ void __launch_bounds__(NWAVES * 64, 2) hybrid_fwd(Args args_unused) {
    extern __shared__ __attribute__((aligned(16))) unsigned char lds[];
    LAS unsigned char* const L = (LAS unsigned char*)lds;
    for (int u = threadIdx.x; u < (LDS_BYTES - LDSCTL_OFF) / 4; u += NWAVES * 64) ((LAS unsigned*)(L + LDSCTL_OFF))[u] = 0u;
    __syncthreads();
    XcdBarrier bar = xcd_barrier_post((unsigned*)((gu32*)(WSP(*KA()) + WS_CTL) + CW_BAR), (volatile LAS unsigned*)(L + MISC_OFF) + 8);
#define GRID_BAR() xcd_barrier(bar)
    { KArgs a = KA(); const Frame F = make_frame(L); p0_prologue(a, F); }
    GRID_BAR();

#pragma nounroll
    for (int l = 0; l < DEPTH; ++l) {
#pragma nounroll
        for (int s = 0; s < 12; ++s) {
            KArgs a = KA(); unsigned char* ws = WSP(*a); unsigned char* r1 = ws + WS_R1; const unsigned char* wl = ws + WS_W + (size_t)l * W_LAYER;
            const int bid = (int)blockIdx.x, G = (int)gridDim.x;
            if (s == 0 || s == 10) {
                pg8::Gemm g = pg8::make_gemm((const bf16*)(ws + WS_HB), (const bf16*)(wl + (s == 0 ? WO_GU1 : WO_GU2)), DMODEL); pg8::StaticOrder S; S.init(M, 2 * DFF, G, bid);
                pg8::EpiSwiGLU E{(bf16*)(r1 + R1_HMID), DFF, (const float*)(ws + WS_STATS)};
                pg8::gemm_phase<pg8::EpiSwiGLU, pg8::StaticOrder, true, true>(L + RING_OFF, g, S, E);
                if (l == 0 && s == 0) {
                    pg8::Gemm gk = pg8::make_gemm((const bf16*)(ws + WS_MEMN), (const bf16*)(ws + WS_WKV), DMODEL); pg8::KvOrder SK{bid - 128};
                    pg8::EpiKV EK{(bf16*)(ws + WS_KC), (bf16*)(ws + WS_VCT)};
                    pg8::gemm_phase<pg8::EpiKV, pg8::KvOrder, true, true>(L + RING_OFF, gk, SK, EK);
                }
            } else if (s == 1 || s == 11) {
                pg8::Gemm g = pg8::make_gemm((const bf16*)(r1 + R1_HMID), (const bf16*)(wl + (s == 1 ? WO_D1 : WO_D2)), DFF); pg8::StaticOrder S; S.init(M, DMODEL, G, bid);
                pg8::EpiResid E{(l == 0 && s == 1) ? INP(*a, 0) : (const float*)OUTP(*a), OUTP(*a), (bf16*)(ws + WS_HB), (float*)(ws + WS_STATS), 0.5f};
                pg8::gemm_phase<pg8::EpiResid, pg8::StaticOrder, false, true>(L + RING_OFF, g, S, E);
            } else if (s == 5 || s == 9) {
                pg8::Gemm g = pg8::make_gemm((const bf16*)(r1 + (s == 5 ? R1_AG : R1_OC)), (const bf16*)(wl + (s == 5 ? WO_OUT : WO_O)), DMODEL); pg8::StaticOrder S; S.init(M, DMODEL, G, bid);
                pg8::EpiResid E{(const float*)OUTP(*a), OUTP(*a), (bf16*)(ws + WS_HB), (float*)(ws + WS_STATS), 1.0f};
                pg8::gemm_phase<pg8::EpiResid, pg8::StaticOrder, false, true>(L + RING_OFF, g, S, E);
            } else if (s == 2) {
                pg8::Gemm g = pg8::make_gemm((const bf16*)(ws + WS_HB), (const bf16*)(wl + WO_IN), DMODEL); pg8::StaticOrder S; S.init(M, DIN, G, bid);
                pg8::EpiWin E{(bf16*)(r1 + R1_Q), (size_t)(R1_T / 2), (const float*)(ws + WS_STATS), (const float*)(ws + WS_CS), C2_DIFF};
                pg8::gemm_phase<pg8::EpiWin, pg8::StaticOrder, true, true>(L + RING_OFF, g, S, E);
            } else if (s == 3) {
                const attn_body::AttnTensors AT{(const attn_body::bf16*)(r1 + R1_Q), (const attn_body::bf16*)(r1 + R1_Q + R1_T), (const attn_body::bf16*)(r1 + R1_Q + 2 * R1_T), (attn_body::bf16*)(r1 + R1_O12)};
                const attn_body::StaticOrder S(G, bid);
                attn_body::attn_phase<attn_body::StaticOrder>((char*)lds + RING_OFF, AT, S);
            } else if (s == 4) {
                const Frame F = make_frame(L); mix2_phase(a, F, l);
            } else if (s == 6) {
                pg8::Gemm g = pg8::make_gemm((const bf16*)(ws + WS_HB), (const bf16*)(wl + WO_Q), DMODEL); pg8::StaticOrder S; S.init(M, DMODEL, G, bid);
                pg8::EpiRowBf16 E{(bf16*)(r1 + R1_QC), DMODEL, (const float*)(ws + WS_STATS), C2_CROSS};
                pg8::gemm_phase<pg8::EpiRowBf16, pg8::StaticOrder, true, true>(L + RING_OFF, g, S, E);
            } else if (s == 7) {
                pg8::Gemm g; g.A = (const bf16*)(r1 + R1_QC); g.Bt = (const bf16*)(ws + WS_KC) + (size_t)l * 512 * 1024; g.lda = 1024; g.ldb = 1024; g.K = 256; g.a_pn = 256; g.b_pn = 256; g.b_batch = 256 * 1024;
                pg8::StaticOrder S; S.init(M, DMODEL, G, bid);
                pg8::EpiScores E{(bf16*)(r1 + R1_P)};
                pg8::gemm_phase<pg8::EpiScores, pg8::StaticOrder, false, true>(L + RING_OFF, g, S, E);
            } else if (s == 8) {
                pg8::Gemm g; g.A = (const bf16*)(r1 + R1_P); g.Bt = (const bf16*)(ws + WS_VCT) + (size_t)l * 2 * 1024 * 256; g.lda = 1024; g.ldb = 256; g.K = 256; g.a_pn = 256; g.b_pn = 256 * 256; g.b_batch = 1024 * 256;
                pg8::StaticOrder S; S.init(M, DMODEL, G, bid);
                pg8::EpiRowBf16 E{(bf16*)(r1 + R1_OC), DMODEL, nullptr, 1.0f};
                pg8::gemm_phase<pg8::EpiRowBf16, pg8::StaticOrder, true, true>(L + RING_OFF, g, S, E);
            }
            GRID_BAR();
        }
    }
    { KArgs a = KA(); const Frame F = make_frame(L); final_norm_phase(a, F); }
#undef GRID_BAR
}

extern "C" void kernel_launch(void* const* d_in, const int* in_sizes, int n_in, void* d_out, int out_size, void* d_ws, size_t ws_size, hipStream_t stream) {
    static int grid = 0;
    if (grid == 0) {
        if (n_in != 27 || in_sizes[0] != M * DMODEL || out_size != M * DMODEL || ws_size < WS_END) { fprintf(stderr, "kernel_launch: unexpected shapes: n_in %d, in0 %d, out %d, ws %zu; nothing launched\n", n_in, n_in > 0 ? in_sizes[0] : -1, out_size, ws_size); grid = -1; return; }
        int dev = 0, cus = 0, per_cu = 0;
        if (hipGetDevice(&dev) != hipSuccess || hipDeviceGetAttribute(&cus, hipDeviceAttributeMultiprocessorCount, dev) != hipSuccess) { fprintf(stderr, "kernel_launch: device query failed\n"); grid = -1; return; }
        if (hipFuncSetAttribute((const void*)hybrid_fwd, hipFuncAttributeMaxDynamicSharedMemorySize, LDS_BYTES) != hipSuccess) { fprintf(stderr, "kernel_launch: hipFuncSetAttribute failed\n"); grid = -1; return; }
        if (hipOccupancyMaxActiveBlocksPerMultiprocessor(&per_cu, (const void*)hybrid_fwd, NWAVES * 64, LDS_BYTES) != hipSuccess || per_cu < 1) { fprintf(stderr, "kernel_launch: occupancy query reports %d workgroups per CU; nothing launched\n", per_cu); (void)hipGetLastError(); grid = -1; return; }
        if (cus < 256) { fprintf(stderr, "kernel_launch: %d CUs; this kernel needs 256 (one workgroup per CU); nothing launched\n", cus); grid = -1; return; }
        grid = 256;
    }
    if (grid < 0) return;
    if (hipMemsetAsync((char*)d_ws + WS_CTL, 0, CTL_ZERO_BYTES, stream) != hipSuccess) { fprintf(stderr, "kernel_launch: hipMemsetAsync failed\n"); return; }
    Args a{};
    for (int i = 0; i < 27; ++i) a.in[i] = (const float*)d_in[i];
    a.out = (float*)d_out; a.ws = (unsigned char*)d_ws;
    hipLaunchKernelGGL(hybrid_fwd, dim3(grid), dim3(NWAVES * 64), LDS_BYTES, stream, a);
    const hipError_t le = hipPeekAtLastError();
    if (le != hipSuccess) fprintf(stderr, "kernel_launch: launch failed: %s\n", hipGetErrorName(le));
}
```

```cpp
#include <hip/hip_runtime.h>
#include <cstdio>
#include <cstdint>
namespace pg8 {
#define PG8_LAS __attribute__((address_space(3)))
typedef unsigned short bf16_t;
typedef short bf16x8 __attribute__((ext_vector_type(8)));
typedef float f32x4 __attribute__((ext_vector_type(4)));
typedef float f32x2 __attribute__((ext_vector_type(2)));
typedef unsigned u32x4 __attribute__((ext_vector_type(4)));
typedef unsigned u32x2 __attribute__((ext_vector_type(2)));
constexpr int BM = 256, BK = 64, HALF = 128, HTB = HALF * BK * 2  , STAGE_BYTES = 8 * HTB, NXCD = 8, WGM = 8;

__host__ __device__ __forceinline__ int lds_byte(int r, int c) { const int st = (r >> 4) * 2 + (c >> 5), rr = r & 15, cc = c & 31, ob = rr * 64 + cc * 2; return st * 1024 + (ob ^ (((ob >> 9) & 1) << 5)); }
__host__ __device__ __forceinline__ void stage_rc(int b, int& R, int& C) { const int st = b / 1024, sb = b % 1024, swz = sb ^ (((sb >> 9) & 1) << 5); R = (st >> 1) * 16 + swz / 64; C = (st & 1) * 32 + (swz % 64) / 2; }
__host__ __device__ __forceinline__ int perm32(int rho) { const int n = rho >> 4, i = rho & 15; return 8 * (i >> 2) + 4 * n + (i & 3); }

struct Unit { int pm, pn; };
struct Gemm { const bf16_t* A; const bf16_t* Bt; int lda, ldb, K; int ash, bsh; long a_hi, a_lo, a_pn, b_hi, b_lo, b_pn; };
__device__ __forceinline__ Gemm make_gemm(const bf16_t* A, const bf16_t* Bt, int K) { Gemm g; g.A = A; g.Bt = Bt; g.lda = K; g.ldb = K; g.K = K; g.ash = 0; g.bsh = 0; g.a_hi = (long)BM * K; g.a_lo = 0; g.a_pn = 0; g.b_hi = 0; g.b_lo = 0; g.b_pn = (long)BM * K; return g; }

struct StaticOrder {
    int nM, nN, nwg, G, c, rot;
    __host__ __device__ void init(int M, int N, int G_, int c_, int rot_ = 0) { nM = M / BM; nN = N / BM; nwg = nM * nN; G = G_; c = c_; rot = rot_; }
    __host__ __device__ bool next(int i, Unit& u) const {
        const long L = (long)i * G + c; if (L >= nwg) return false;
        int wgid = (int)L; { const int q = nwg / NXCD, r = nwg % NXCD, xcd = wgid % NXCD, off = wgid / NXCD; wgid = (xcd < r ? xcd * (q + 1) : r * (q + 1) + (xcd - r) * q) + off; }
        const int nig = WGM * nN, gid = wgid / nig, fm = gid * WGM, gsz = (nM - fm) < WGM ? (nM - fm) : WGM;
        u.pm = fm + ((wgid % nig) % gsz); u.pn = (wgid % nig) / gsz + rot; if (u.pn >= nN) u.pn -= nN; return true;
    }
    __device__ __forceinline__ void a_ready(const Unit&) const {}
    __device__ __forceinline__ void done(const Unit&) const {}
};
struct KvOrder {
    int j, l;
    __device__ __forceinline__ bool next(int i, Unit& u) const { if (i != 0 || j < 0 || j >= 16) return false; u.pm = j & 1; u.pn = 8 * l + (j >> 1); return true; }
    __device__ __forceinline__ void a_ready(const Unit&) const {}
    __device__ __forceinline__ void done(const Unit&) const {}
};
struct PreOrder {
    int j;
    __device__ __forceinline__ bool next(int i, Unit& u) const { if (i != 0 || j < 0 || j >= 32) return false; u.pm = j >> 2; u.pn = j & 3; return true; }
    __device__ __forceinline__ void a_ready(const Unit&) const {}
    __device__ __forceinline__ void done(const Unit&) const {}
};

__device__ __forceinline__ unsigned cvt_pk_bf16(float lo, float hi) { unsigned r; asm volatile("v_cvt_pk_bf16_f32 %0, %1, %2" : "=v"(r) : "v"(lo), "v"(hi)); return r; }
__device__ __forceinline__ f32x2 gelu_pk(f32x2 v) {
    const f32x2 av = __builtin_elementwise_abs(v), d = av * 0.2316418882f + 1.0f;
    f32x2 t; t.x = __builtin_amdgcn_rcpf(d.x); t.y = __builtin_amdgcn_rcpf(d.y);
    f32x2 q = t * 0.5307027145f + (-0.7265760135f); q = q * t + 0.7107068705f; q = q * t + (-0.142248368f); q = q * t + 0.127414796f; q = q * t;
    const f32x2 s = (v * v) * (-0.72134752044f);
    f32x2 e; e.x = __builtin_amdgcn_exp2f(s.x); e.y = __builtin_amdgcn_exp2f(s.y);
    const f32x2 m = v * (q * e), r = v - m;
    f32x2 o; o.x = v.x < 0.f ? m.x : r.x; o.y = v.y < 0.f ? m.y : r.y; return o;
}
__device__ __forceinline__ f32x4 gelu4(f32x4 v) { const f32x2 a = gelu_pk((f32x2){v[0], v[1]}), b = gelu_pk((f32x2){v[2], v[3]}); return (f32x4){a.x, a.y, b.x, b.y}; }
__device__ __forceinline__ float silu1(float g) { return g * __builtin_amdgcn_rcpf(1.0f + __builtin_amdgcn_exp2f(g * -1.4426950408889634f)); }
__device__ __forceinline__ float rs_from_stats(const float* stats, int row) { const f32x4 s = *(const f32x4*)(stats + (size_t)row * 4); return __builtin_amdgcn_rsqf(((s[0] + s[1]) + (s[2] + s[3])) * (1.0f / 1024.0f) + 1e-6f); }


struct EpiSwiGLU {
    static constexpr bool PERM = true, AFTER_DRAIN = false;
    bf16_t* O; int ldc; const float* stats;
    __device__ __forceinline__ void operator()(const f32x4 (&acc)[2][2][4][2], const Unit& u, int wr, int wc, int fr, int fq) const {
        const int row0 = u.pm * BM + wr * 64 + fr, col0 = u.pn * HALF + wc * 32 + 8 * fq;
#pragma unroll
        for (int ai = 0; ai < 2; ++ai)
#pragma unroll
            for (int m = 0; m < 4; ++m) { const int row = row0 + ai * HALF + m * 16; const float r = rs_from_stats(stats, row); const float c = r * -1.4426950408889634f, r2 = r * r;
                u32x4 w; unsigned ww[4];
#pragma unroll
                for (int n = 0; n < 2; ++n) {
                    const f32x4 g = acc[ai][0][m][n], up = acc[ai][1][m][n]; const f32x4 t = (g * up) * r2, ea = g * c; f32x4 e, s;
#pragma unroll
                    for (int i = 0; i < 4; ++i) e[i] = __builtin_amdgcn_exp2f(ea[i]);
                    e = e + 1.0f;
#pragma unroll
                    for (int i = 0; i < 4; ++i) s[i] = __builtin_amdgcn_rcpf(e[i]);
                    const f32x4 o = t * s; ww[2 * n] = cvt_pk_bf16(o[0], o[1]); ww[2 * n + 1] = cvt_pk_bf16(o[2], o[3]); }
                w.x = ww[0]; w.y = ww[1]; w.z = ww[2]; w.w = ww[3];
                *(u32x4*)(O + (size_t)row * ldc + col0) = w; }
    }
};

struct EpiWin {
    static constexpr bool PERM = true, AFTER_DRAIN = false;
    bf16_t* O5; size_t ostride; const float* stats; const float* cs; float qscale;
    __device__ __forceinline__ void operator()(const f32x4 (&acc)[2][2][4][2], const Unit& u, int wr, int wc, int fr, int fq) const {
        const int typ = u.pn >> 1; bf16_t* base = O5 + (size_t)typ * ostride;
        const int row0 = u.pm * BM + wr * 64 + fr, col0 = (u.pn & 1) * BM + wc * 32 + 8 * fq;
        const bool rot = (typ < 2) && ((wc & 1) == 0);
        const float sgn = (fq == 0) ? -1.0f : 1.0f; const bool rl = fq < 2; const float qs = (typ == 0) ? qscale : 1.0f;
#pragma unroll
        for (int ai = 0; ai < 2; ++ai)
#pragma unroll
            for (int m = 0; m < 4; ++m) { const int row = row0 + ai * HALF + m * 16; const float r = rs_from_stats(stats, row);
                f32x4 cc[2], sn[2];
                if (rot) { cc[0] = *(const f32x4*)(cs + (size_t)row * 16); cc[1] = *(const f32x4*)(cs + (size_t)row * 16 + 4); sn[0] = *(const f32x4*)(cs + (size_t)row * 16 + 8); sn[1] = *(const f32x4*)(cs + (size_t)row * 16 + 12); }
#pragma unroll
                for (int bj = 0; bj < 2; ++bj) { f32x4 v0 = acc[ai][bj][m][0] * r, v1 = acc[ai][bj][m][1] * r;
                    if (rot) {
                        f32x4 p0, p1;
#pragma unroll
                        for (int i = 0; i < 4; ++i) { p0[i] = __shfl_xor(v0[i], 16); p1[i] = __shfl_xor(v1[i], 16); }
                        const f32x4 n0 = v0 * cc[0] + (p0 * sn[0]) * sgn, n1 = v1 * cc[1] + (p1 * sn[1]) * sgn;
                        if (rl) { v0 = n0; v1 = n1; }
                    }
                    if (typ >= 3) { v0 = gelu4(v0); v1 = gelu4(v1); }
                    v0 = v0 * qs; v1 = v1 * qs;
                    u32x4 w; w.x = cvt_pk_bf16(v0[0], v0[1]); w.y = cvt_pk_bf16(v0[2], v0[3]); w.z = cvt_pk_bf16(v1[0], v1[1]); w.w = cvt_pk_bf16(v1[2], v1[3]);
                    *(u32x4*)(base + (size_t)row * 512 + col0 + bj * HALF) = w; } }
    }
};

struct EpiRowBf16 {
    static constexpr bool PERM = true, AFTER_DRAIN = false;
    bf16_t* O; int ldc; const float* stats; float sc;
    __device__ __forceinline__ void operator()(const f32x4 (&acc)[2][2][4][2], const Unit& u, int wr, int wc, int fr, int fq) const {
        const int row0 = u.pm * BM + wr * 64 + fr, col0 = u.pn * BM + wc * 32 + 8 * fq;
#pragma unroll
        for (int ai = 0; ai < 2; ++ai)
#pragma unroll
            for (int m = 0; m < 4; ++m) { const int row = row0 + ai * HALF + m * 16; const float r = (stats ? rs_from_stats(stats, row) : 1.0f) * sc;
#pragma unroll
                for (int bj = 0; bj < 2; ++bj) { const f32x4 v0 = acc[ai][bj][m][0] * r, v1 = acc[ai][bj][m][1] * r;
                    u32x4 w; w.x = cvt_pk_bf16(v0[0], v0[1]); w.y = cvt_pk_bf16(v0[2], v0[3]); w.z = cvt_pk_bf16(v1[0], v1[1]); w.w = cvt_pk_bf16(v1[2], v1[3]);
                    *(u32x4*)(O + (size_t)row * ldc + col0 + bj * HALF) = w; } }
    }
};

struct EpiKV {
    static constexpr bool PERM = true, AFTER_DRAIN = false;
    bf16_t* Kc; size_t vc_off;
    __device__ __forceinline__ void operator()(const f32x4 (&acc)[2][2][4][2], const Unit& u, int wr, int wc, int fr, int fq) const {
        const int layer = u.pn >> 3, t = u.pn & 7;
        const int row0 = u.pm * BM + wr * 64 + fr;
        bf16_t* base = Kc + (size_t)(t >> 2) * vc_off + (size_t)layer * 512 * 1024; const int col0 = (t & 3) * BM + wc * 32 + 8 * fq;
#pragma unroll
        for (int ai = 0; ai < 2; ++ai)
#pragma unroll
            for (int m = 0; m < 4; ++m) { const int row = row0 + ai * HALF + m * 16;
#pragma unroll
                for (int bj = 0; bj < 2; ++bj) { const f32x4 v0 = acc[ai][bj][m][0], v1 = acc[ai][bj][m][1];
                    u32x4 w; w.x = cvt_pk_bf16(v0[0], v0[1]); w.y = cvt_pk_bf16(v0[2], v0[3]); w.z = cvt_pk_bf16(v1[0], v1[1]); w.w = cvt_pk_bf16(v1[2], v1[3]);
                    *(u32x4*)(base + (size_t)row * 1024 + col0 + bj * HALF) = w; } }
    }
};

__device__ __forceinline__ float bflo(unsigned w) { return __uint_as_float(w << 16); }
__device__ __forceinline__ float bfhi(unsigned w) { return __uint_as_float(w & 0xffff0000u); }
struct EpiResid {
    static constexpr bool PERM = true, AFTER_DRAIN = true;
    const float* xin; bf16_t* hb; bf16_t* lo; float* stats; float alpha;
    __device__ __forceinline__ void fused(f32x4 (&acc)[2][2][4][2], const Unit& u, int wr, int wc, int fr, int fq, PG8_LAS unsigned char* lds, int wid, int lane) const {
        PG8_LAS float* P = (PG8_LAS float*)lds;
        const int col0 = u.pn * BM + wc * 32 + 8 * fq;
        const size_t off0 = (size_t)(u.pm * BM + wr * 64 + fr) * 1024 + col0;
#define RES_STEP(AI, M_, BJ, H) do { u32x4 hw; \
            _Pragma("unroll") for (int e = 0; e < 4; ++e) { const float o0 = (H)[2 * e] + acc[AI][BJ][M_][e >> 1][(2 * e) & 3] * alpha, o1 = (H)[2 * e + 1] + acc[AI][BJ][M_][e >> 1][(2 * e + 1) & 3] * alpha; \
                hw[e] = cvt_pk_bf16(o0, o1); ss += o0 * o0 + o1 * o1; } \
            *(u32x4*)(hb + off0 + (size_t)((AI) * HALF + (M_) * 16) * 1024 + (BJ) * HALF) = hw; } while (0)
        if (xin) {
#pragma unroll
            for (int ai = 0; ai < 2; ++ai)
#pragma unroll
                for (int m = 0; m < 4; ++m) { float ss = 0.f;
#pragma unroll
                    for (int bj = 0; bj < 2; ++bj) { const size_t o8 = off0 + (size_t)(ai * HALF + m * 16) * 1024 + bj * HALF; const f32x4 a = *(const f32x4*)(xin + o8), b = *(const f32x4*)(xin + o8 + 4);
                        const float h[8] = {a[0], a[1], a[2], a[3], b[0], b[1], b[2], b[3]}; RES_STEP(ai, m, bj, h); }
                    ss += __shfl_xor(ss, 16); ss += __shfl_xor(ss, 32);
                    if (fq == 0) P[(ai * HALF + wr * 64 + m * 16 + fr) * 4 + wc] = ss;
                    if (m & 1) asm volatile("" ::: "memory"); }
        } else {
            u32x4 hv[2][4][2];
#pragma unroll
            for (int ai = 0; ai < 2; ++ai)
#pragma unroll
                for (int m = 0; m < 4; ++m)
#pragma unroll
                    for (int bj = 0; bj < 2; ++bj) hv[ai][m][bj] = *(const u32x4*)(hb + off0 + (size_t)(ai * HALF + m * 16) * 1024 + bj * HALF);
#pragma unroll
            for (int ai = 0; ai < 2; ++ai)
#pragma unroll
                for (int m = 0; m < 4; ++m) { float ss = 0.f;
#pragma unroll
                    for (int bj = 0; bj < 2; ++bj) { const u32x4 w4 = hv[ai][m][bj];
                        const float h[8] = {bflo(w4[0]), bfhi(w4[0]), bflo(w4[1]), bfhi(w4[1]), bflo(w4[2]), bfhi(w4[2]), bflo(w4[3]), bfhi(w4[3])}; RES_STEP(ai, m, bj, h); }
                    ss += __shfl_xor(ss, 16); ss += __shfl_xor(ss, 32);
                    if (fq == 0) P[(ai * HALF + wr * 64 + m * 16 + fr) * 4 + wc] = ss; }
        }
#undef RES_STEP
        asm volatile("s_waitcnt lgkmcnt(0)" ::: "memory"); __builtin_amdgcn_s_barrier(); asm volatile("" ::: "memory");
        const int tid = wid * 64 + lane;
        if (tid < 256) { const f32x4 p = *(const PG8_LAS f32x4*)(P + tid * 4); stats[(size_t)(u.pm * BM + tid) * 4 + u.pn] = (p[0] + p[1]) + (p[2] + p[3]); }
        asm volatile("s_waitcnt lgkmcnt(0)" ::: "memory"); __builtin_amdgcn_s_barrier(); asm volatile("" ::: "memory");
    }
};

struct EpiResidFinal {
    static constexpr bool PERM = true, AFTER_DRAIN = true;
    const bf16_t* hb; float* stats; const float* gain; float* out; unsigned* cnt; float alpha;
    __device__ __forceinline__ void fused(f32x4 (&acc)[2][2][4][2], const Unit& u, int wr, int wc, int fr, int fq, PG8_LAS unsigned char* lds, int wid, int lane) const {
        PG8_LAS float* P = (PG8_LAS float*)lds;
        const int col0 = u.pn * BM + wc * 32 + 8 * fq;
        const size_t off0 = (size_t)(u.pm * BM + wr * 64 + fr) * 1024 + col0;
        { u32x4 hv[2][4][2];
#pragma unroll
          for (int ai = 0; ai < 2; ++ai)
#pragma unroll
              for (int m = 0; m < 4; ++m)
#pragma unroll
                  for (int bj = 0; bj < 2; ++bj) hv[ai][m][bj] = *(const u32x4*)(hb + off0 + (size_t)(ai * HALF + m * 16) * 1024 + bj * HALF);
#pragma unroll
          for (int ai = 0; ai < 2; ++ai)
#pragma unroll
              for (int m = 0; m < 4; ++m) { float ss = 0.f;
#pragma unroll
                  for (int bj = 0; bj < 2; ++bj) { const u32x4 w4 = hv[ai][m][bj];
#pragma unroll
                      for (int n = 0; n < 2; ++n) { f32x4 o = acc[ai][bj][m][n] * alpha;
                          o[0] += bflo(w4[2 * n]); o[1] += bfhi(w4[2 * n]); o[2] += bflo(w4[2 * n + 1]); o[3] += bfhi(w4[2 * n + 1]);
                          ss += (o[0] * o[0] + o[1] * o[1]) + (o[2] * o[2] + o[3] * o[3]); acc[ai][bj][m][n] = o; } }
                  ss += __shfl_xor(ss, 16); ss += __shfl_xor(ss, 32);
                  if (fq == 0) P[(ai * HALF + wr * 64 + m * 16 + fr) * 4 + wc] = ss; } }
        asm volatile("s_waitcnt lgkmcnt(0)" ::: "memory"); __builtin_amdgcn_s_barrier(); asm volatile("" ::: "memory");
        const int tid = wid * 64 + lane;
        if (tid < 256) { const f32x4 p = *(const PG8_LAS f32x4*)(P + tid * 4); stats[(size_t)(u.pm * BM + tid) * 4 + u.pn] = (p[0] + p[1]) + (p[2] + p[3]); }
        asm volatile("s_waitcnt vmcnt(0) lgkmcnt(0)" ::: "memory"); __builtin_amdgcn_s_barrier(); asm volatile("" ::: "memory");
        if (tid == 0) { unsigned* c = cnt + u.pm * 16;
            __builtin_amdgcn_fence(__ATOMIC_RELEASE, "agent"); asm volatile("s_waitcnt vmcnt(0)" ::: "memory");
            (void)__hip_atomic_fetch_add(c, 1u, __ATOMIC_RELAXED, __HIP_MEMORY_SCOPE_AGENT);
            unsigned sp = 0u; while (__hip_atomic_load(c, __ATOMIC_RELAXED, __HIP_MEMORY_SCOPE_AGENT) < 4u && ++sp < (1u << 22)) __builtin_amdgcn_s_sleep(1);
            __builtin_amdgcn_fence(__ATOMIC_ACQUIRE, "agent"); asm volatile("s_waitcnt vmcnt(0)" ::: "memory"); }
        __builtin_amdgcn_s_barrier(); asm volatile("" ::: "memory");
        f32x4 g4[2][2];
#pragma unroll
        for (int bj = 0; bj < 2; ++bj)
#pragma unroll
            for (int n = 0; n < 2; ++n) g4[bj][n] = *(const f32x4*)(gain + col0 + bj * HALF + 4 * n);
#pragma unroll
        for (int ai = 0; ai < 2; ++ai)
#pragma unroll
            for (int m = 0; m < 4; ++m) { const int row = u.pm * BM + ai * HALF + wr * 64 + m * 16 + fr; const float r = rs_from_stats(stats, row);
#pragma unroll
                for (int bj = 0; bj < 2; ++bj)
#pragma unroll
                    for (int n = 0; n < 2; ++n) *(f32x4*)(out + (size_t)row * 1024 + col0 + bj * HALF + 4 * n) = acc[ai][bj][m][n] * r * g4[bj][n]; }
    }
};

struct EpiScores {
    static constexpr bool PERM = true, AFTER_DRAIN = true;
    bf16_t* Pm; const float* stats;
    __device__ __forceinline__ void fused(f32x4 (&acc)[2][2][4][2], const Unit& u, int wr, int wc, int fr, int fq, PG8_LAS unsigned char* lds, int wid, int lane) const {
        PG8_LAS f32x2* PX = (PG8_LAS f32x2*)lds;
        float mw[2][4];
#pragma unroll
        for (int ai = 0; ai < 2; ++ai)
#pragma unroll
            for (int m = 0; m < 4; ++m) { const int rl = ai * HALF + wr * 64 + m * 16 + fr; float a = -3.0e38f; const float rs = rs_from_stats(stats, u.pm * BM + rl);
#pragma unroll
                for (int bj = 0; bj < 2; ++bj)
#pragma unroll
                    for (int n = 0; n < 2; ++n) { const f32x4 x = acc[ai][bj][m][n] * rs; acc[ai][bj][m][n] = x; a = fmaxf(a, fmaxf(fmaxf(x[0], x[1]), fmaxf(x[2], x[3]))); }
                a = fmaxf(a, __shfl_xor(a, 16)); a = fmaxf(a, __shfl_xor(a, 32)); mw[ai][m] = a; float s = 0.f;
#pragma unroll
                for (int bj = 0; bj < 2; ++bj)
#pragma unroll
                    for (int n = 0; n < 2; ++n) { f32x4 x = acc[ai][bj][m][n];
#pragma unroll
                        for (int i = 0; i < 4; ++i) { x[i] = __builtin_amdgcn_exp2f(x[i] - a); s += x[i]; }
                        acc[ai][bj][m][n] = x; }
                s += __shfl_xor(s, 16); s += __shfl_xor(s, 32);
                if (fq == 0) PX[rl * 4 + wc] = (f32x2){a, s}; }
        asm volatile("s_waitcnt lgkmcnt(0)" ::: "memory"); __builtin_amdgcn_s_barrier(); asm volatile("" ::: "memory");
        const int col0 = u.pn * BM + wc * 32 + 8 * fq;
#pragma unroll
        for (int ai = 0; ai < 2; ++ai)
#pragma unroll
            for (int m = 0; m < 4; ++m) { const int rl = ai * HALF + wr * 64 + m * 16 + fr;
                const f32x4 p01 = *(const PG8_LAS f32x4*)(PX + rl * 4), p23 = *(const PG8_LAS f32x4*)(PX + rl * 4 + 2);
                const float mrow = fmaxf(fmaxf(p01[0], p01[2]), fmaxf(p23[0], p23[2]));
                const float l = (p01[1] * __builtin_amdgcn_exp2f(p01[0] - mrow) + p01[3] * __builtin_amdgcn_exp2f(p01[2] - mrow)) + (p23[1] * __builtin_amdgcn_exp2f(p23[0] - mrow) + p23[3] * __builtin_amdgcn_exp2f(p23[2] - mrow));
                const float inv = __builtin_amdgcn_exp2f(mw[ai][m] - mrow) * __builtin_amdgcn_rcpf(l);
#pragma unroll
                for (int bj = 0; bj < 2; ++bj) { const f32x4 v0 = acc[ai][bj][m][0] * inv, v1 = acc[ai][bj][m][1] * inv;
                    u32x4 w; w.x = cvt_pk_bf16(v0[0], v0[1]); w.y = cvt_pk_bf16(v0[2], v0[3]); w.z = cvt_pk_bf16(v1[0], v1[1]); w.w = cvt_pk_bf16(v1[2], v1[3]);
                    *(u32x4*)(Pm + (size_t)(u.pm * BM + rl) * 1024 + col0 + bj * HALF) = w; } }
        asm volatile("s_waitcnt lgkmcnt(0)" ::: "memory"); __builtin_amdgcn_s_barrier(); asm volatile("" ::: "memory");
    }
};

template <class Epi, class Sched, bool ALIGN_EPI = false, bool SP2 = false>
__device__ __forceinline__ void gemm_phase(PG8_LAS unsigned char* lds, const Gemm g, const Sched& S, const Epi& E) {
    int tid_ = threadIdx.x; asm volatile("" : "+v"(tid_));
    int wid_ = __builtin_amdgcn_readfirstlane(tid_ >> 6); asm volatile("" : "+s"(wid_));
    const int tid = tid_, wid = wid_, lane = tid & 63, wr = wid >> 2, wc = wid & 3, fr = lane & 15, fq = lane >> 4;
    const int K = g.K, nt = K / BK;
    unsigned voffA[2], voffB[2];
#pragma unroll
    for (int i = 0; i < 2; ++i) { int R, C; stage_rc(tid * 16 + i * 8192, R, C); const int Rb = Epi::PERM ? ((R & ~31) + perm32(R & 31)) : R;
        voffA[i] = (unsigned)(R * g.lda + C) * 2u; voffB[i] = (unsigned)(Rb * g.ldb + C) * 2u; }
    const size_t kstep = (size_t)(BK * 2);
    const size_t hstepA = (size_t)HALF * g.lda * 2, hstepB = (size_t)HALF * g.ldb * 2;
    const unsigned ldsw = (unsigned)wid * 1024u;
    const int aoff = lds_byte(wr * 64 + fr, fq * 8), boff = lds_byte(wc * 32 + fr, fq * 8);
#define PG8_ABASE(u) ((const char*)(g.A + ((size_t)((u).pm >> g.ash) * g.a_hi + (size_t)((u).pm & ((1 << g.ash) - 1)) * g.a_lo + (size_t)(u).pn * g.a_pn)))
#define PG8_BBASE(u) ((const char*)(g.Bt + ((size_t)((u).pm >> g.bsh) * g.b_hi + (size_t)((u).pm & ((1 << g.bsh) - 1)) * g.b_lo + (size_t)(u).pn * g.b_pn)))
#define PG8_SA(b, h) (((b) * 2 + (h)) * HTB)
#define PG8_SB(b, h) ((4 + (b) * 2 + (h)) * HTB)
#define PG8_STAGE(bufoff, gbase, voff) do { _Pragma("unroll") for (int _i = 0; _i < 2; ++_i) \
        __builtin_amdgcn_global_load_lds((const unsigned*)((const char*)(gbase) + (voff)[_i]), (PG8_LAS unsigned*)(lds + (bufoff) + ldsw + _i * 8192), 16, 0, 0); } while (0)
#define PG8_LDA(dst, b, h) do { _Pragma("unroll") for (int m = 0; m < 4; ++m) _Pragma("unroll") for (int k = 0; k < 2; ++k) dst[m][k] = *(const PG8_LAS bf16x8*)(lds + PG8_SA(b, h) + aoff + m * 2048 + k * 1024); } while (0)
#define PG8_LDB(dst, b, h) do { _Pragma("unroll") for (int n = 0; n < 2; ++n) _Pragma("unroll") for (int k = 0; k < 2; ++k) dst[n][k] = *(const PG8_LAS bf16x8*)(lds + PG8_SB(b, h) + boff + n * 2048 + k * 1024); } while (0)
#define PG8_MMA(ai, bj, At, Bt) do { __builtin_amdgcn_s_setprio(1); _Pragma("unroll") for (int m = 0; m < 4; ++m) _Pragma("unroll") for (int n = 0; n < 2; ++n) _Pragma("unroll") for (int k = 0; k < 2; ++k) \
        acc[ai][bj][m][n] = __builtin_amdgcn_mfma_f32_16x16x32_bf16(Bt[n][k], At[m][k], acc[ai][bj][m][n], 0, 0, 0); __builtin_amdgcn_s_setprio(0); } while (0)
#define PG8_WAIT_V(n) asm volatile("s_waitcnt vmcnt(" #n ")" ::: "memory")
#define PG8_WAIT_L(n) asm volatile("s_waitcnt lgkmcnt(" #n ")" ::: "memory")
#define PG8_BAR __builtin_amdgcn_s_barrier()
#define PG8_SCHED __builtin_amdgcn_sched_barrier(0)
    Unit cur, nxt; int ui = 0;
    if (!S.next(0, cur)) return;
    f32x4 acc[2][2][4][2];
#pragma unroll
    for (int a = 0; a < 2; ++a)
#pragma unroll
        for (int b = 0; b < 2; ++b)
#pragma unroll
            for (int m = 0; m < 4; ++m)
#pragma unroll
                for (int n = 0; n < 2; ++n) acc[a][b][m][n] = (f32x4){0.f, 0.f, 0.f, 0.f};
    bf16x8 At[4][2], B0[2][2], B1[2][2];
    const char* cA = PG8_ABASE(cur); const char* cB = PG8_BBASE(cur);
    S.a_ready(cur);
    if constexpr (SP2) {
        PG8_STAGE(PG8_SB(0, 0), cB, voffB); PG8_STAGE(PG8_SB(0, 1), cB + hstepB, voffB); PG8_STAGE(PG8_SA(0, 0), cA, voffA); PG8_STAGE(PG8_SA(0, 1), cA + hstepA, voffA);
        PG8_STAGE(PG8_SB(1, 0), cB + kstep, voffB); PG8_STAGE(PG8_SA(1, 0), cA + kstep, voffA); PG8_STAGE(PG8_SB(1, 1), cB + hstepB + kstep, voffB);
        if (wr == 1) PG8_BAR;
        PG8_WAIT_V(8); PG8_BAR;
        PG8_WAIT_V(6); PG8_BAR;
    } else {
        PG8_STAGE(PG8_SB(0, 0), cB, voffB); PG8_STAGE(PG8_SA(0, 0), cA, voffA); PG8_STAGE(PG8_SB(0, 1), cB + hstepB, voffB); PG8_STAGE(PG8_SA(0, 1), cA + hstepA, voffA);
        if (wr == 1) PG8_BAR;
        PG8_WAIT_V(4); PG8_BAR;
        PG8_STAGE(PG8_SB(1, 0), cB + kstep, voffB); PG8_STAGE(PG8_SA(1, 0), cA + kstep, voffA); PG8_STAGE(PG8_SB(1, 1), cB + hstepB + kstep, voffB);
        PG8_WAIT_V(6); PG8_BAR;
    }
    for (;;) {
        const bool has_next = S.next(ui + 1, nxt);
        const char* nA = has_next ? PG8_ABASE(nxt) : cA; const char* nB = has_next ? PG8_BBASE(nxt) : cB;
        for (int t = 0; t < nt; t += 2) {
            const bool last = (t == nt - 2);
            const char* a1 = cA + (size_t)(t + 1) * kstep;
            const char* a2 = last ? nA : cA + (size_t)(t + 2) * kstep; const char* b2 = last ? nB : cB + (size_t)(t + 2) * kstep;
            const char* a3 = a2 + kstep; const char* b3 = b2 + kstep;
            if (last && has_next) S.a_ready(nxt);
            if constexpr (SP2) {
            PG8_LDB(B0, 0, 0); PG8_LDB(B1, 0, 1); PG8_SCHED; PG8_LDA(At, 0, 0); PG8_STAGE(PG8_SA(1, 1), a1 + hstepA, voffA);
            PG8_WAIT_V(8); PG8_WAIT_L(0); PG8_BAR; PG8_MMA(0, 0, At, B0); PG8_MMA(0, 1, At, B1); PG8_BAR; PG8_SCHED;
            PG8_LDA(At, 0, 1); PG8_STAGE(PG8_SB(0, 0), b2, voffB); PG8_STAGE(PG8_SB(0, 1), b2 + hstepB, voffB); PG8_STAGE(PG8_SA(0, 0), a2, voffA);
            PG8_WAIT_V(8); PG8_WAIT_L(0); PG8_BAR; PG8_MMA(1, 0, At, B0); PG8_MMA(1, 1, At, B1); PG8_BAR; PG8_SCHED;
            PG8_LDB(B0, 1, 0); PG8_LDB(B1, 1, 1); PG8_SCHED; PG8_LDA(At, 1, 0); PG8_STAGE(PG8_SA(0, 1), a2 + hstepA, voffA);
            PG8_WAIT_V(8); PG8_WAIT_L(0); PG8_BAR; PG8_MMA(0, 0, At, B0); PG8_MMA(0, 1, At, B1); PG8_BAR; PG8_SCHED;
            PG8_LDA(At, 1, 1); PG8_STAGE(PG8_SB(1, 0), b3, voffB); PG8_STAGE(PG8_SB(1, 1), b3 + hstepB, voffB); PG8_STAGE(PG8_SA(1, 0), a3, voffA);
            PG8_WAIT_V(8); PG8_WAIT_L(0); PG8_BAR; PG8_MMA(1, 0, At, B0); PG8_MMA(1, 1, At, B1); PG8_BAR; PG8_SCHED;
            } else {
            PG8_LDB(B0, 0, 0); PG8_SCHED; PG8_LDA(At, 0, 0); PG8_STAGE(PG8_SA(1, 1), a1 + hstepA, voffA);
            PG8_WAIT_L(8); PG8_BAR; PG8_WAIT_L(0); PG8_MMA(0, 0, At, B0); PG8_BAR; PG8_SCHED;
            PG8_LDB(B1, 0, 1); PG8_STAGE(PG8_SB(0, 0), b2, voffB);
            PG8_BAR; PG8_WAIT_L(0); PG8_MMA(0, 1, At, B1); PG8_BAR;
            PG8_LDA(At, 0, 1); PG8_STAGE(PG8_SA(0, 0), a2, voffA);
            PG8_BAR; PG8_WAIT_L(0); PG8_MMA(1, 0, At, B0); PG8_BAR; PG8_SCHED;
            PG8_STAGE(PG8_SB(0, 1), b2 + hstepB, voffB);
            PG8_WAIT_V(6); PG8_BAR; PG8_MMA(1, 1, At, B1); PG8_BAR;
            PG8_LDB(B0, 1, 0); PG8_SCHED; PG8_LDA(At, 1, 0); PG8_STAGE(PG8_SA(0, 1), a2 + hstepA, voffA);
            PG8_WAIT_L(8); PG8_BAR; PG8_WAIT_L(0); PG8_MMA(0, 0, At, B0); PG8_BAR; PG8_SCHED;
            PG8_LDB(B1, 1, 1); PG8_STAGE(PG8_SB(1, 0), b3, voffB);
            PG8_BAR; PG8_WAIT_L(0); PG8_MMA(0, 1, At, B1); PG8_BAR;
            PG8_LDA(At, 1, 1); PG8_STAGE(PG8_SA(1, 0), a3, voffA);
            PG8_BAR; PG8_WAIT_L(0); PG8_MMA(1, 0, At, B0); PG8_BAR; PG8_SCHED;
            PG8_STAGE(PG8_SB(1, 1), b3 + hstepB, voffB);
            PG8_WAIT_V(6); PG8_BAR; PG8_MMA(1, 1, At, B1); PG8_BAR;
            }
        }
        if constexpr (ALIGN_EPI) { if (wr == 0) PG8_BAR; }
        if constexpr (!Epi::AFTER_DRAIN) { E(acc, cur, wr, wc, fr, fq); S.done(cur); }
        if (!has_next) break;
#pragma unroll
        for (int a = 0; a < 2; ++a)
#pragma unroll
            for (int b = 0; b < 2; ++b)
#pragma unroll
                for (int m = 0; m < 4; ++m)
#pragma unroll
                    for (int n = 0; n < 2; ++n) acc[a][b][m][n] = (f32x4){0.f, 0.f, 0.f, 0.f};
        cur = nxt; cA = nA; cB = nB; ++ui;
        if constexpr (ALIGN_EPI) { if (wr == 1) PG8_BAR; }
    }
    PG8_WAIT_V(0);
    if constexpr (!ALIGN_EPI) { if (wr == 0) PG8_BAR; }
    PG8_BAR;
    if constexpr (Epi::AFTER_DRAIN) { E.fused(acc, cur, wr, wc, fr, fq, lds, wid, lane); S.done(cur); }
#undef PG8_ABASE
#undef PG8_BBASE
#undef PG8_SA
#undef PG8_SB
#undef PG8_STAGE
#undef PG8_LDA
#undef PG8_LDB
#undef PG8_MMA
#undef PG8_WAIT_V
#undef PG8_WAIT_L
#undef PG8_BAR
#undef PG8_SCHED
}
}
#include <hip/hip_bf16.h>
#include <cmath>
namespace attn_body {
using bf16=__hip_bfloat16;
using bf16x8=__attribute__((ext_vector_type(8)))short;
using s16x4=__attribute__((ext_vector_type(4)))short;
using f32x16=__attribute__((ext_vector_type(16)))float;
using u32x4=__attribute__((ext_vector_type(4)))unsigned;
constexpr int BATCH=2,NHEAD=8,SEQ=8192,D=64,DV=128,QKP=512,OP=1024;
constexpr int NW=8,QBLK=32,QB=QBLK*NW,KVBLK=64,NQB=SEQ/QB;
constexpr int ATTN_UNIT_ROWS=QB;
__device__ __forceinline__ int crow(int r,int hi){return (r&3)+8*(r>>2)+4*hi;}
#define SBAR() __builtin_amdgcn_sched_barrier(0)
__device__ __forceinline__ void cmask(f32x16&p0,f32x16&p1,int jb,int qrel,int hi){
  const float NEG=-INFINITY; int kb=64*jb+4*hi;
  #pragma unroll
  for(int r=0;r<16;++r){int kv=kb+(r&3)+8*(r>>2); if(kv>qrel)p0[r]=NEG; if(kv+32>qrel)p1[r]=NEG;}
}

constexpr int NSLOT=3, SLOTB=8192;
constexpr int SLOTV=2*SLOTB;
constexpr int NKS=4;
constexpr int LDS_K=0, LDS_V=NKS*SLOTB, LDS_WS=LDS_V+NSLOT*SLOTV, LDS_OST=LDS_WS+NW*64*4, LDS_BYTES=LDS_OST+NW*4096;
constexpr float C2=0.125f*1.4426950408889634f;
__device__ __forceinline__ void glds16(const void*gsrc,unsigned lds_dst){unsigned keep;
  asm volatile("s_mov_b32 %0, m0\n\ts_mov_b32 m0, %2\n\ts_nop 0\n\tglobal_load_lds_dwordx4 %1, off\n\ts_mov_b32 m0, %0":"=&s"(keep):"v"(gsrc),"s"(lds_dst):"memory");}
__device__ __forceinline__ float max3f(float a,float b,float c){float r;asm("v_max3_f32 %0, %1, %2, %3":"=v"(r):"v"(a),"v"(b),"v"(c));return r;}
__device__ __forceinline__ float max2f(float a,float b){float r;asm("v_max_f32_e32 %0, %1, %2":"=v"(r):"v"(a),"v"(b));return r;}
__device__ __forceinline__ float fadd_s(float a,float b){float r;asm("v_add_f32_e32 %0, %1, %2":"=v"(r):"v"(a),"v"(b));return r;}
__device__ __forceinline__ float fsub_s(float a,float b){float r;asm("v_sub_f32_e32 %0, %1, %2":"=v"(r):"v"(a),"v"(b));return r;}
typedef float f32x2_t __attribute__((ext_vector_type(2))); typedef __bf16 bf16x2_t __attribute__((ext_vector_type(2)));
__device__ __forceinline__ unsigned cvtpk_s(float lo,float hi){f32x2_t v={lo,hi};bf16x2_t b=__builtin_convertvector(v,bf16x2_t);return __builtin_bit_cast(unsigned,b);}
#define WAIT_BAR(N) asm volatile("s_waitcnt vmcnt(" #N ") lgkmcnt(0)\n\ts_barrier":::"memory")

__device__ __forceinline__ void qkt(f32x16&p0,f32x16&p1,const char*Kslot,const bf16x8*qr,int r32,int hi){
  const f32x16 negm=f32x16{};
  const char*kb=Kslot+hi*1024+r32*16;
  #pragma unroll
  for(int d0=0;d0<4;++d0){
    const bf16x8 b0=*reinterpret_cast<const bf16x8*>(kb+d0*2048);
    const bf16x8 b1=*reinterpret_cast<const bf16x8*>(kb+d0*2048+512);
    if(d0==0){p0=__builtin_amdgcn_mfma_f32_32x32x16_bf16(b0,qr[0],negm,0,0,0);p1=__builtin_amdgcn_mfma_f32_32x32x16_bf16(b1,qr[0],negm,0,0,0);}
    else{p0=__builtin_amdgcn_mfma_f32_32x32x16_bf16(b0,qr[d0],p0,0,0,0);p1=__builtin_amdgcn_mfma_f32_32x32x16_bf16(b1,qr[d0],p1,0,0,0);}}
}
typedef __attribute__((address_space(3))) const char* lds_cptr;
typedef short v4i16_t __attribute__((ext_vector_type(4)));
__device__ __forceinline__ void kload8(bf16x8*kf,lds_cptr kp){
  kf[0]=*(const __attribute__((address_space(3))) bf16x8*)(kp);      kf[1]=*(const __attribute__((address_space(3))) bf16x8*)(kp+512);
  kf[2]=*(const __attribute__((address_space(3))) bf16x8*)(kp+2048); kf[3]=*(const __attribute__((address_space(3))) bf16x8*)(kp+2560);
  kf[4]=*(const __attribute__((address_space(3))) bf16x8*)(kp+4096); kf[5]=*(const __attribute__((address_space(3))) bf16x8*)(kp+4608);
  kf[6]=*(const __attribute__((address_space(3))) bf16x8*)(kp+6144); kf[7]=*(const __attribute__((address_space(3))) bf16x8*)(kp+6656);
}
__device__ __forceinline__ bf16x8 kload1(lds_cptr kp,int i){ return *(const __attribute__((address_space(3))) bf16x8*)(kp+(i>>1)*2048+(i&1)*512); }
__device__ __forceinline__ void kload2(bf16x8*kf,lds_cptr kp,int j){ kf[2*j]=*(const __attribute__((address_space(3))) bf16x8*)(kp+j*2048); kf[2*j+1]=*(const __attribute__((address_space(3))) bf16x8*)(kp+j*2048+512); }
__device__ __forceinline__ s16x4 vtr(lds_cptr p){ return __builtin_bit_cast(s16x4,__builtin_amdgcn_ds_read_tr16_b64_v4i16((__attribute__((address_space(3))) v4i16_t*)p)); }
__device__ __forceinline__ float rowmax(const f32x16&p0,const f32x16&p1){
  float a=max3f(p0[0],p0[1],p1[0]),b=max3f(p0[2],p0[3],p1[1]);a=max3f(a,p1[2],p1[3]);
  #pragma unroll
  for(int r=4;r<16;r+=4){a=max3f(a,p0[r],p0[r+1]);b=max3f(b,p0[r+2],p0[r+3]);a=max3f(a,p1[r],p1[r+1]);b=max3f(b,p1[r+2],p1[r+3]);}
  const float m=max2f(a,b);
  auto rr=__builtin_amdgcn_permlane32_swap(__float_as_uint(m),__float_as_uint(m),false,false);
  return max2f(__uint_as_float(rr[0]),__uint_as_float(rr[1]));
}
__device__ __forceinline__ void pv(f32x16*o,int vb,bf16x8 pa0,bf16x8 pa1,bf16x8 pa2,bf16x8 pa3){
  #pragma unroll
  for(int d0=0;d0<4;++d0){s16x4 lo[4],hi[4];
    #pragma unroll
    for(int ks=0;ks<4;++ks){
      asm volatile("ds_read_b64_tr_b16 %0,%1 offset:%c2":"=&v"(lo[ks]):"v"(vb),"i"(d0*4096+ks*1024):"memory");
      asm volatile("ds_read_b64_tr_b16 %0,%1 offset:%c2":"=&v"(hi[ks]):"v"(vb),"i"(d0*4096+ks*1024+512):"memory");}
    asm volatile("s_waitcnt lgkmcnt(0)":::"memory");SBAR();
    #define PK(k) (bf16x8){lo[k][0],lo[k][1],lo[k][2],lo[k][3],hi[k][0],hi[k][1],hi[k][2],hi[k][3]}
    o[d0]=__builtin_amdgcn_mfma_f32_32x32x16_bf16(pa0,PK(0),o[d0],0,0,0);
    o[d0]=__builtin_amdgcn_mfma_f32_32x32x16_bf16(pa1,PK(1),o[d0],0,0,0);
    o[d0]=__builtin_amdgcn_mfma_f32_32x32x16_bf16(pa2,PK(2),o[d0],0,0,0);
    o[d0]=__builtin_amdgcn_mfma_f32_32x32x16_bf16(pa3,PK(3),o[d0],0,0,0);
    #undef PK
  }
}

#ifndef ATTN_STORE16
#define ATTN_STORE16(p,v) (*(u32x4*)(p)=(v))
#endif
template<int THRL> __device__ __forceinline__ void attn_unit(int b,int hm,int qb,const bf16*Q,const bf16*__restrict__ K,const bf16*__restrict__ V,bf16*O,char*shm){
  const int qkcol=(hm>>1)*128+(hm&1)*64, vcol=(hm>>1)*128, ocol=(hm&1)*512+(hm>>1)*128;
  int tid_=threadIdx.x; asm volatile("":"+v"(tid_)); int wid_=__builtin_amdgcn_readfirstlane(tid_>>6); asm volatile("":"+s"(wid_));
  const int tid=tid_,lane=tid&63,r32=lane&31,hi=lane>>5; const int wid=wid_;
  const long rowbase=(long)b*SEQ; const int q0=qb*QB;
  const bf16*Qw=Q+(rowbase+q0+wid*QBLK)*QKP+qkcol;
  const bf16*Kh=K+rowbase*QKP+qkcol,*Vh=V+rowbase*QKP+vcol;
  const unsigned lds0=(unsigned)(uintptr_t)shm;
  float*wsf=(float*)(shm+LDS_WS)+wid*64;
  const bf16*ksrc=Kh+(long)lane*QKP+wid*8;
  const bf16*vsrc=Vh+(long)(16*(wid&3)+(lane>>2))*QKP+(wid>>2)*32+(lane&3)*8;
  const unsigned kdst=lds0+LDS_K+wid*1024, vdst=lds0+LDS_V+wid*1024;
  #define KSL(t) ((((t))&3)*SLOTB)
  #define DMA_K(t,slot) glds16(ksrc+(long)(t)*KVBLK*QKP,(unsigned)__builtin_amdgcn_readfirstlane(kdst+(slot)))
  #define DMA_V(t,slot) do{ glds16(vsrc+(long)(t)*KVBLK*QKP,(unsigned)__builtin_amdgcn_readfirstlane(vdst+2*(slot))); glds16(vsrc+64+(long)(t)*KVBLK*QKP,(unsigned)__builtin_amdgcn_readfirstlane(vdst+2*(slot)+8192)); }while(0)
  const int vb0=(int)(lds0+LDS_V)+((lane>>4)&1)*32+(lane&3)*8+(4*hi+((lane&15)>>2))*64;
  const char*Kbase=shm+LDS_K; bf16x8 kf[8];
  const lds_cptr shm3=(lds_cptr)shm; const lds_cptr kp0=shm3+LDS_K+hi*1024+r32*16; const lds_cptr vp0=shm3+LDS_V+((lane>>4)&1)*32+(lane&3)*8+(4*hi+((lane&15)>>2))*64;
  const int NT=(q0+QB)/KVBLK;
  DMA_K(0,0);DMA_V(0,0);DMA_K(1,SLOTB);
  bf16x8 qr[4];
  #pragma unroll
  for(int d0=0;d0<4;++d0)qr[d0]=*reinterpret_cast<const bf16x8*>(&Qw[(long)r32*QKP+d0*16+hi*8]);
  float mhat=0.f,l_reg=0.f;f32x16 o[4];o[0]=f32x16{};o[1]=f32x16{};o[2]=f32x16{};o[3]=f32x16{};f32x16 negm=f32x16{};asm volatile("":"+v"(negm));
  const int qrel=wid*QBLK+r32;
  #define CMASK(P0,P1,t) do{int jb_=(t)-(NT-4); if(jb_>=0)cmask(P0,P1,jb_,qrel,hi);}while(0)
  bool resc=false;
  #define START(P0,P1) do{ const float rm=rowmax(P0,P1); resc=false; \
    { const float dl=rm; mhat=fadd_s(mhat,dl); \
      _Pragma("unroll") for(int r=0;r<16;++r){P0[r]=fsub_s(P0[r],dl);P1[r]=fsub_s(P1[r],dl);} \
      _Pragma("unroll") for(int r=0;r<16;++r)negm[r]=-mhat; asm volatile("":"+v"(negm)); } \
    _Pragma("unroll") for(int r=0;r<16;++r)P0[r]=__builtin_amdgcn_exp2f(P0[r]); }while(0)
  #define RESC() do{ if(resc){ asm volatile("s_waitcnt lgkmcnt(0)":::"memory"); \
      _Pragma("unroll") for(int d_=0;d_<4;++d_) _Pragma("unroll") for(int r=0;r<16;++r)o[d_][r]*=wsf[crow(r,hi)]; } }while(0)
  f32x16 pA0,pA1,pB0,pB1;
  int sl_prev=0,sl_cur=0,sl_next=SLOTB;
  #define ROT() do{sl_prev=sl_cur;sl_cur=sl_next;sl_next=(sl_next==(NSLOT-1)*SLOTB)?0:sl_next+SLOTB;}while(0)
  DMA_K(2,2*SLOTB);
  WAIT_BAR(4);
  qkt(pA0,pA1,Kbase,qr,r32,hi);asm volatile("s_nop 15\n\ts_nop 7":"+v"(pA0),"+v"(pA1));CMASK(pA0,pA1,0);
  START(pA0,pA1);
  _Pragma("unroll") for(int r=0;r<16;++r)pA1[r]=__builtin_amdgcn_exp2f(pA1[r]);
  WAIT_BAR(0);
  DMA_K(3,3*SLOTB);DMA_V(1,SLOTB);
  ROT();
  kload2(kf,kp0+KSL(1),0);
  WAIT_BAR(3);
  s16x4 vlo[8],vhi[8]; u32x4 pw0,pw1,pw2,pw3;
  #define PKW(P,B) cvtpk_s(P[B],P[B+1])
  #define PAF(k) __builtin_bit_cast(bf16x8,pw##k)
  #define VFR(i) (bf16x8){vlo[i][0],vlo[i][1],vlo[i][2],vlo[i][3],vhi[i][0],vhi[i][1],vhi[i][2],vhi[i][3]}
  #define PIN(x) asm volatile("":"+v"(x))
  #define MX3(a,b,c) __builtin_fmaxf(__builtin_fmaxf((a),(b)),(c))
  #define GAPA(MF,A0,A1,A2,A3,W0,W1,PW) do{ MF; sacc+=A0; sacc+=A1; sacc+=A2; sacc+=A3; PIN(sacc); W0; W1; PIN(PW); SBAR(); }while(0)
  #define EX(v) __builtin_amdgcn_exp2f(v)
  #define GAPB(MF,X,B) do{ MF; X[B]=EX(X[B]); X[B+1]=EX(X[B+1]); PIN(X); SBAR(); }while(0)
  #define VRD2(i) do{ vlo[i]=vtr(vp_+((2+((i)>>2))*4096+((i)&3)*1024)); vhi[i]=vtr(vp_+((2+((i)>>2))*4096+((i)&3)*1024+512)); }while(0)
  #define VRD(i) do{ vlo[i]=vtr(vp_+(((i)>>2)*4096+((i)&3)*1024)); vhi[i]=vtr(vp_+(((i)>>2)*4096+((i)&3)*1024+512)); }while(0)
  #define KRD(G,j) do{ if(G){ kload2(kf,kp0+sl_next,j); SBAR(); } }while(0)
  #define STEP(C0,C1,P0,P1,t,GK,GV,GL) do{ SBAR(); \
    const lds_cptr vp_=vp0+2*sl_prev; const lds_cptr kq_=kp0+KSL(t); \
    VRD(0); kf[2]=kload1(kq_,2); SBAR(); float sacc=(P0[0]+P0[1]); \
    GAPA(C0=__builtin_amdgcn_mfma_f32_32x32x16_bf16(kf[0],qr[0],negm,0,0,0), P0[2],P0[3],P0[4],P0[5],     pw0[0]=PKW(P0,0), pw0[1]=PKW(P0,2), pw0); \
    VRD(4); kf[3]=kload1(kq_,3); SBAR(); GAPA(C1=__builtin_amdgcn_mfma_f32_32x32x16_bf16(kf[1],qr[0],negm,0,0,0), P0[6],P0[7],P0[8],P0[9],     pw0[2]=PKW(P0,4), pw0[3]=PKW(P0,6), pw0); \
    VRD(1); kf[4]=kload1(kq_,4); SBAR(); GAPA(C0=__builtin_amdgcn_mfma_f32_32x32x16_bf16(kf[2],qr[1],C0,0,0,0),   P0[10],P0[11],P0[12],P0[13], pw1[0]=PKW(P0,8), pw1[1]=PKW(P0,10), pw1); \
    VRD(5); kf[5]=kload1(kq_,5); SBAR(); GAPA(C1=__builtin_amdgcn_mfma_f32_32x32x16_bf16(kf[3],qr[1],C1,0,0,0),   P0[14],P0[15],P1[0],P1[1],   pw1[2]=PKW(P0,12),pw1[3]=PKW(P0,14), pw1); \
    VRD(2); kf[6]=kload1(kq_,6); SBAR(); GAPA(C0=__builtin_amdgcn_mfma_f32_32x32x16_bf16(kf[4],qr[2],C0,0,0,0),   P1[2],P1[3],P1[4],P1[5],     pw2[0]=PKW(P1,0), pw2[1]=PKW(P1,2), pw2); \
    VRD(6); kf[7]=kload1(kq_,7); SBAR(); GAPA(C1=__builtin_amdgcn_mfma_f32_32x32x16_bf16(kf[5],qr[2],C1,0,0,0),   P1[6],P1[7],P1[8],P1[9],     pw2[2]=PKW(P1,4), pw2[3]=PKW(P1,6), pw2); \
    VRD(3); SBAR(); GAPA(C0=__builtin_amdgcn_mfma_f32_32x32x16_bf16(kf[6],qr[3],C0,0,0,0),   P1[10],P1[11],P1[12],P1[13], pw3[0]=PKW(P1,8), pw3[1]=PKW(P1,10), pw3); \
    VRD(7); SBAR(); GAPA(C1=__builtin_amdgcn_mfma_f32_32x32x16_bf16(kf[7],qr[3],C1,0,0,0),   P1[14],P1[15],0.f,0.f,       pw3[2]=PKW(P1,12),pw3[3]=PKW(P1,14), pw3); \
    l_reg+=sacc; \
    if(GK){DMA_K((t)+3,KSL((t)+3));} if(GV){DMA_V((t)+1,sl_next);} \
    CMASK(C0,C1,t); \
    { float a=MX3(C0[0],C0[1],C1[0]),b=MX3(C0[2],C0[3],C1[1]); a=MX3(a,C1[2],C1[3]); \
      _Pragma("unroll") for(int r=4;r<16;r+=4){a=MX3(a,C0[r],C0[r+1]);b=MX3(b,C0[r+2],C0[r+3]);a=MX3(a,C1[r],C1[r+1]);b=MX3(b,C1[r+2],C1[r+3]);} \
      float rm=__builtin_fmaxf(a,b); { auto rr=__builtin_amdgcn_permlane32_swap(__float_as_uint(rm),__float_as_uint(rm),false,false); rm=__builtin_fmaxf(__uint_as_float(rr[0]),__uint_as_float(rr[1])); } \
      resc=false; \
      if(__builtin_expect(__any(rm>(float)THRL),0)){ const float dl=__builtin_fmaxf(rm,0.f); mhat+=dl; \
        _Pragma("unroll") for(int r=0;r<16;++r){C0[r]-=dl;C1[r]-=dl;} \
        _Pragma("unroll") for(int r=0;r<16;++r)negm[r]=-mhat; asm volatile("":"+v"(negm)); \
        const float f=__builtin_amdgcn_exp2f(-dl); l_reg*=f; if(hi==0)wsf[r32]=f; resc=true; } } \
    SBAR(); \
    GAPB(o[0]=__builtin_amdgcn_mfma_f32_32x32x16_bf16(PAF(0),VFR(0),o[0],0,0,0), C0,0);  VRD2(0); SBAR(); \
    GAPB(o[1]=__builtin_amdgcn_mfma_f32_32x32x16_bf16(PAF(0),VFR(4),o[1],0,0,0), C0,2);  VRD2(4); SBAR(); \
    GAPB(o[0]=__builtin_amdgcn_mfma_f32_32x32x16_bf16(PAF(1),VFR(1),o[0],0,0,0), C0,4);  VRD2(1); SBAR(); \
    GAPB(o[1]=__builtin_amdgcn_mfma_f32_32x32x16_bf16(PAF(1),VFR(5),o[1],0,0,0), C0,6);  VRD2(5); SBAR(); \
    GAPB(o[0]=__builtin_amdgcn_mfma_f32_32x32x16_bf16(PAF(2),VFR(2),o[0],0,0,0), C0,8);  VRD2(2); SBAR(); \
    GAPB(o[1]=__builtin_amdgcn_mfma_f32_32x32x16_bf16(PAF(2),VFR(6),o[1],0,0,0), C0,10); VRD2(6); SBAR(); \
    GAPB(o[0]=__builtin_amdgcn_mfma_f32_32x32x16_bf16(PAF(3),VFR(3),o[0],0,0,0), C0,12); VRD2(3); SBAR(); \
    GAPB(o[1]=__builtin_amdgcn_mfma_f32_32x32x16_bf16(PAF(3),VFR(7),o[1],0,0,0), C0,14); VRD2(7); SBAR(); \
    GAPB(o[2]=__builtin_amdgcn_mfma_f32_32x32x16_bf16(PAF(0),VFR(0),o[2],0,0,0), C1,0); \
    GAPB(o[3]=__builtin_amdgcn_mfma_f32_32x32x16_bf16(PAF(0),VFR(4),o[3],0,0,0), C1,2); \
    GAPB(o[2]=__builtin_amdgcn_mfma_f32_32x32x16_bf16(PAF(1),VFR(1),o[2],0,0,0), C1,4); \
    GAPB(o[3]=__builtin_amdgcn_mfma_f32_32x32x16_bf16(PAF(1),VFR(5),o[3],0,0,0), C1,6); \
    GAPB(o[2]=__builtin_amdgcn_mfma_f32_32x32x16_bf16(PAF(2),VFR(2),o[2],0,0,0), C1,8); \
    GAPB(o[3]=__builtin_amdgcn_mfma_f32_32x32x16_bf16(PAF(2),VFR(6),o[3],0,0,0), C1,10); \
    GAPB(o[2]=__builtin_amdgcn_mfma_f32_32x32x16_bf16(PAF(3),VFR(3),o[2],0,0,0), C1,12); \
    GAPB(o[3]=__builtin_amdgcn_mfma_f32_32x32x16_bf16(PAF(3),VFR(7),o[3],0,0,0), C1,14); \
    if(GL){ kload2(kf,kp0+KSL((t)+1),0); SBAR(); } \
    }while(0)
  int t=1;
  #undef CMASK
  #define CMASK(P0,P1,t) do{}while(0)
  for(;t+5<NT;t+=2){
    STEP(pB0,pB1,pA0,pA1,t,true,true,true);     WAIT_BAR(3); RESC(); ROT();
    STEP(pA0,pA1,pB0,pB1,t+1,true,true,true);   WAIT_BAR(3); RESC(); ROT();
  }
  #undef CMASK
  #define CMASK(P0,P1,t) do{int jb_=(t)-(NT-4); if(jb_>=0)cmask(P0,P1,jb_,qrel,hi);}while(0)
  #define ENDW(tt) do{ if((tt)+3<NT){WAIT_BAR(3);} else if((tt)+2<NT){WAIT_BAR(2);} else {WAIT_BAR(0);} }while(0)
  for(;t+1<NT;t+=2){
    STEP(pB0,pB1,pA0,pA1,t,(t+3<NT),(t+1<NT),(t+1<NT));       ENDW(t);   RESC(); ROT();
    STEP(pA0,pA1,pB0,pB1,t+1,(t+4<NT),(t+2<NT),(t+2<NT));     ENDW(t+1); RESC(); ROT();
  }
  STEP(pB0,pB1,pA0,pA1,NT-1,false,false,false); RESC();
  { float sacc=pB0[0]+pB0[1]; _Pragma("unroll") for(int r=2;r<16;++r)sacc+=pB0[r]; _Pragma("unroll") for(int r=0;r<16;++r)sacc+=pB1[r]; l_reg+=sacc;
    pw0=(u32x4){PKW(pB0,0),PKW(pB0,2),PKW(pB0,4),PKW(pB0,6)};pw1=(u32x4){PKW(pB0,8),PKW(pB0,10),PKW(pB0,12),PKW(pB0,14)};pw2=(u32x4){PKW(pB1,0),PKW(pB1,2),PKW(pB1,4),PKW(pB1,6)};pw3=(u32x4){PKW(pB1,8),PKW(pB1,10),PKW(pB1,12),PKW(pB1,14)};
    SBAR(); pv(o,vb0+2*sl_cur,PAF(0),PAF(1),PAF(2),PAF(3)); }
  #undef PKW
  #undef PAF
  #undef VFR
  #undef PIN
  #undef MX3
  #undef GAPA
  #undef GAPB
  #undef EX
  #undef VRD
  #undef VRD2
  #undef KRD
  #undef STEP
  #undef ENDW
  {auto rr=__builtin_amdgcn_permlane32_swap(__float_as_uint(l_reg),__float_as_uint(l_reg),false,false);l_reg=__uint_as_float(rr[0])+__uint_as_float(rr[1]);}
  if(hi==0)wsf[32+r32]=l_reg;asm volatile("s_waitcnt lgkmcnt(0)":::"memory");
  float rli[16];
  #pragma unroll
  for(int r=0;r<16;++r)rli[r]=__builtin_amdgcn_rcpf(wsf[32+crow(r,hi)]);
  bf16*Ow=O+(rowbase+q0+wid*QBLK)*OP+ocol;
  { bf16*stg=(bf16*)(shm+LDS_OST)+wid*2048;
    #pragma unroll
    for(int p=0;p<2;++p){
      #pragma unroll
      for(int r=0;r<16;++r){const int orow=crow(r,hi);
        #pragma unroll
        for(int d0=0;d0<2;++d0)stg[orow*64+d0*32+r32]=__float2bfloat16(o[2*p+d0][r]*rli[r]);}
      asm volatile("s_waitcnt lgkmcnt(0)":::"memory");
      #pragma unroll
      for(int i=0;i<4;++i){const int row=i*8+(lane>>3),ch=lane&7; const u32x4 v=*(const u32x4*)(stg+row*64+ch*8); ATTN_STORE16(Ow+(long)row*OP+p*64+ch*8,v);}
      asm volatile("s_waitcnt lgkmcnt(0)":::"memory"); } }
  asm volatile("s_waitcnt lgkmcnt(0)\n\ts_barrier":::"memory");
  #undef DMA_K
  #undef DMA_V
  #undef CMASK
  #undef START
  #undef RESC
  #undef ROT
}
constexpr int ATTN_LDS_BYTES=LDS_BYTES;
struct AttnTensors { const bf16* Q; const bf16* K; const bf16* V; bf16* O; };
struct AttnUnit { int bh; int qb; };
struct StaticOrder {
  int vcu;
  __device__ __forceinline__ explicit StaticOrder(int grid,int block):vcu((block%8)*(grid/8)+block/8){}
  __device__ __forceinline__ bool next(int i,AttnUnit&u)const{ if(i>=2)return false; const int s=vcu&15; u.bh=vcu>>4; u.qb=(i==0)?s:31-s; return true; }
  __device__ __forceinline__ void a_ready(const AttnUnit&)const{}
  __device__ __forceinline__ void done(const AttnUnit&)const{}
};
template<class Sched,int THRL=8> __device__ __forceinline__ void attn_phase(char*lds,const AttnTensors&T,const Sched&S){
  AttnUnit u;
  for(int i=0;S.next(i,u);++i){ S.a_ready(u); attn_unit<THRL>(u.bh/NHEAD,u.bh%NHEAD,u.qb,T.Q,T.K,T.V,T.O,lds); S.done(u); }
}
#undef SBAR
#undef WAIT_BAR
}
#define GAS __attribute__((address_space(1)))
#define LAS __attribute__((address_space(3)))
typedef unsigned short bf16;
typedef unsigned v4u __attribute__((ext_vector_type(4)));
typedef float f32x4 __attribute__((ext_vector_type(4)));
typedef short bf16x8 __attribute__((ext_vector_type(8)));
typedef GAS unsigned gu32;
typedef GAS unsigned long long gu64;
#define RLX_AGENT __ATOMIC_RELAXED, __HIP_MEMORY_SCOPE_AGENT
#define LDS_WAIT() asm volatile("s_waitcnt lgkmcnt(0)" ::: "memory")
#define VM_WAIT() asm volatile("s_waitcnt vmcnt(0)" ::: "memory")
__device__ __forceinline__ unsigned long long rt() { return __builtin_amdgcn_s_memrealtime(); }
__device__ __forceinline__ unsigned f2bf(float f) { unsigned u = __builtin_bit_cast(unsigned, f); return (u + 0x7fffu + ((u >> 16) & 1u)) >> 16; }
__device__ __forceinline__ unsigned pk2(float lo, float hi) { return f2bf(lo) | (f2bf(hi) << 16); }

#define XB_TMO      128
#define XB_XCNT(j)  (256  + 64 * (j))
#define XB_XSUB(j)  (1280 + 64 * (j))
#define XB_XGEN(j)  (2304 + 64 * (j))
#define XB_TOP      3328
#define XB_TOPGEN   3392
#define XCD_BAR_WORDS 3456
#define XB_SPIN_CAP (1u << 18)

__device__ __forceinline__ unsigned xb_ld(unsigned* p)              { return __hip_atomic_load(p, __ATOMIC_RELAXED, __HIP_MEMORY_SCOPE_AGENT); }
__device__ __forceinline__ unsigned xb_add(unsigned* p, unsigned v) { return __hip_atomic_fetch_add(p, v, __ATOMIC_RELAXED, __HIP_MEMORY_SCOPE_AGENT); }
__device__ __forceinline__ unsigned xb_xcc_id() { return (unsigned)__builtin_amdgcn_s_getreg((3 << 11) | 20) & 0xFu; }
#define XB_SPIN(cond, bar) do { unsigned _sp = 0; while (cond) { __builtin_amdgcn_s_sleep(1); \
    if ((++_sp & 255u) == 0u) { if (xb_ld(&(bar)[XB_TMO])) break; if (_sp > XB_SPIN_CAP) { atomicAdd(&(bar)[XB_TMO], 1u); break; } } } } while (0)

struct XcdBarrier {
    unsigned* bar; unsigned x;
    volatile LAS unsigned* st;
};

__device__ __forceinline__ XcdBarrier xcd_barrier_post(unsigned* bar, volatile LAS unsigned* st) {
    XcdBarrier b; b.bar = bar; b.x = xb_xcc_id(); b.st = st;
    if (threadIdx.x == 0) (void)xb_add(&bar[XB_XCNT(b.x)], 1u);
    return b;
}
__device__ __forceinline__ void xcd_barrier_complete(unsigned* bar, unsigned x, unsigned& nloc, unsigned& nx) {
    const unsigned G = gridDim.x * gridDim.y * gridDim.z;
    unsigned sum, cnt, mine, sp = 0u;
    for (;;) {
        sum = 0u; cnt = 0u; mine = 0u;
#pragma unroll
        for (unsigned j = 0; j < 16; ++j) { const unsigned c = xb_ld(&bar[XB_XCNT(j)]); sum += c; cnt += (c > 0u) ? 1u : 0u; mine = (j == x) ? c : mine; }
        if (sum == G) break;
        __builtin_amdgcn_s_sleep(1);
        if ((++sp & 255u) == 0u) { if (xb_ld(&bar[XB_TMO])) break; if (sp > XB_SPIN_CAP) { atomicAdd(&bar[XB_TMO], 1u); break; } }
    }
    nloc = mine > 0u ? mine : 1u; nx = cnt > 0u ? cnt : 1u;
}

__device__ __forceinline__ void xcd_barrier(const XcdBarrier& b) {
    asm volatile("s_waitcnt vmcnt(0)" ::: "memory");
    __syncthreads();
    if (threadIdx.x == 0) {
        unsigned* bar = b.bar; const unsigned bx = (unsigned)__builtin_amdgcn_readfirstlane((int)xb_xcc_id());
        __builtin_amdgcn_s_waitcnt(0);
        unsigned nloc = b.st[0], nx = b.st[1];
        if (nloc == 0u) { xcd_barrier_complete(bar, bx, nloc, nx); b.st[0] = nloc; b.st[1] = nx; }
        const unsigned old = xb_add(&bar[XB_XSUB(bx)], 1u);
        const unsigned gen = old / nloc;
        if (old + 1u == (gen + 1u) * nloc) {
            __builtin_amdgcn_fence(__ATOMIC_RELEASE, "agent");
            asm volatile("s_waitcnt vmcnt(0)" ::: "memory");
            const unsigned og = xb_add(&bar[XB_TOP], 1u);
            const unsigned tg = og / nx;
            if (og + 1u == (tg + 1u) * nx) xb_add(&bar[XB_TOPGEN], 1u);
            else XB_SPIN(xb_ld(&bar[XB_TOPGEN]) == tg, bar);
            __builtin_amdgcn_fence(__ATOMIC_ACQUIRE, "agent");
            xb_add(&bar[XB_XGEN(bx)], 1u);
            asm volatile("s_waitcnt vmcnt(0)" ::: "memory");
        } else {
            XB_SPIN(xb_ld(&bar[XB_XGEN(bx)]) == gen, bar);
            __builtin_amdgcn_fence(__ATOMIC_ACQUIRE, "agent");
            asm volatile("s_waitcnt vmcnt(0)" ::: "memory");
        }
    }
    __syncthreads();
}

#ifndef REPMASK
#define REPMASK 0
#endif
constexpr int NWAVES = 8;
constexpr int BATCH = 2, SEQ = 8192, DMODEL = 1024, DEPTH = 2, NMEM = 256, DFF = 2816, DIN = 2560;
constexpr int M = BATCH * SEQ;
constexpr float C2_DIFF = 0.125f * 1.4426950408889634f;
constexpr float C2_CROSS = 0.0625f * 1.4426950408889634f;
constexpr size_t MiB = 1u << 20;
constexpr size_t WS_CTL = 0, CTL_ZERO_BYTES = 64 * 1024;
constexpr size_t WS_STATS = 1 * MiB;
constexpr size_t WS_CS = 2 * MiB;
constexpr size_t WS_MEMN = 3 * MiB;
constexpr size_t WS_KC = 4 * MiB;
constexpr size_t WS_VC = 6 * MiB;
constexpr size_t WS_W = 8 * MiB;
constexpr size_t W_GU = (size_t)2 * DFF * DMODEL * 2, W_D = (size_t)DMODEL * DFF * 2, W_IN = (size_t)DIN * DMODEL * 2, W_SQ = (size_t)DMODEL * DMODEL * 2;
constexpr size_t WO_GU1 = 0, WO_D1 = WO_GU1 + W_GU, WO_IN = WO_D1 + W_D, WO_OUT = WO_IN + W_IN, WO_Q = WO_OUT + W_SQ, WO_O = WO_Q + W_SQ, WO_GU2 = WO_O + W_SQ, WO_D2 = WO_GU2 + W_GU, W_LAYER = WO_D2 + W_D;
constexpr size_t WS_WKV = WS_W + W_LAYER;
constexpr size_t WS_HB = 60 * MiB;
constexpr size_t WS_LO = 92 * MiB;
constexpr size_t WS_X1 = WS_LO;
constexpr size_t WS_X2 = WS_LO + 8 * MiB;
constexpr size_t WS_R1 = 124 * MiB;
constexpr size_t R1_HMID = 0;
constexpr size_t R1_Q = 0, R1_T = 16 * MiB;
constexpr size_t R1_O12 = 80 * MiB;
constexpr size_t R1_AG = 0;
constexpr size_t R1_P = 32 * MiB;
constexpr size_t WS_END = 236 * MiB;
static_assert(W_LAYER == 44 * MiB && WS_WKV + (size_t)2 * 2048 * 1024 * 2 == WS_HB && WS_HB + (size_t)M * 1024 * 2 == WS_LO && WS_LO + 32 * MiB == WS_R1 && WS_R1 + 112 * MiB == WS_END, "d_ws map");
constexpr int CW_BAR = 4096;
constexpr int CW_PANEL = 12288;
static_assert((CW_PANEL + 64 * 16) * 4 <= 64 * 1024, "panel counters inside the memset region");
constexpr int RING_OFF = 0, RING_BYTES = 131072;
constexpr int LDSCTL_OFF = RING_BYTES, MISC_OFF = LDSCTL_OFF + 320;
constexpr int LDS_BYTES = 147456;
static_assert(MISC_OFF + 128 <= LDS_BYTES, "LDS map");
static_assert((CW_BAR + 3456) * 4 <= (int)CTL_ZERO_BYTES, "CTL words inside the memset region");

struct Args { const float* in[27]; float* out; unsigned char* ws; };
typedef const __attribute__((address_space(4))) Args* KArgs;
#define AS1(T, p) ((T*)(__attribute__((address_space(1))) T*)(p))
#define INP(a, i) AS1(const float, (a).in[i])
#define OUTP(a) AS1(float, (a).out)
#define WSP(a) AS1(unsigned char, (a).ws)

__device__ __forceinline__ float wave_sum(float v) {
#pragma unroll
    for (int o = 1; o < 64; o <<= 1) v += __shfl_xor(v, o);
    return v;
}
struct TJob { const float* src; const float* gain; bf16* dst; int N, K, k0, n0, d0; bool plain; };
struct TTile { f32x4 v[16]; float g[16]; };
__device__ __forceinline__ void tr_load(const TJob& j, TTile& t, int lane) {
    const int q = lane & 15, r = lane >> 4;
#pragma unroll
    for (int i = 0; i < 8; ++i)
#pragma unroll
        for (int h = 0; h < 2; ++h) { const int k = j.k0 + 8 * i + 2 * r + h;
            t.v[2 * i + h] = *(const GAS f32x4*)(j.src + (size_t)k * j.N + j.n0 + 4 * q); t.g[2 * i + h] = j.gain ? j.gain[k] : 1.0f; }
}
__device__ __forceinline__ void tr_store(const TJob& j, const TTile& t, LAS unsigned* T, int lane) {
    const int q = lane & 15, r = lane >> 4;
    if (j.plain) {
#pragma unroll
        for (int i = 0; i < 8; ++i)
#pragma unroll
            for (int h = 0; h < 2; ++h) { const f32x4 a = t.v[2 * i + h] * t.g[2 * i + h]; const int k = j.k0 + 8 * i + 2 * r + h;
                *(GAS unsigned long long*)(j.dst + (size_t)k * j.N + j.n0 + 4 * q) = (unsigned long long)pg8::cvt_pk_bf16(a[0], a[1]) | ((unsigned long long)pg8::cvt_pk_bf16(a[2], a[3]) << 32); }
        return;
    }
#pragma unroll
    for (int i = 0; i < 8; ++i) { const f32x4 a = t.v[2 * i] * t.g[2 * i], b = t.v[2 * i + 1] * t.g[2 * i + 1]; const int kp = r + 4 * i;
#pragma unroll
        for (int e = 0; e < 4; ++e) T[(4 * q + e) * 33 + kp] = pg8::cvt_pk_bf16(a[e], b[e]); }
    LDS_WAIT(); asm volatile("" ::: "memory");
    const int c = lane & 7;
#pragma unroll
    for (int jj = 0; jj < 8; ++jj) { const int n = (lane >> 3) + 8 * jj; const LAS unsigned* s = T + n * 33 + 4 * c;
        v4u o; o.x = s[0]; o.y = s[1]; o.z = s[2]; o.w = s[3];
        *(GAS v4u*)(j.dst + (size_t)(j.d0 + n) * j.K + j.k0 + 8 * c) = o; }
    LDS_WAIT(); asm volatile("" ::: "memory");
}
__device__ __forceinline__ void sincos_d(float af, float& sn, float& cs) {
    const double a = (double)af; const double kq = __builtin_rint(a * 0.6366197723675814); const double r = __builtin_fma(-kq, 1.5707963267948966, a) - kq * 6.123233995736766e-17;
    const double r2 = r * r;
    const double sp = r * (1.0 + r2 * (-1.0 / 6 + r2 * (1.0 / 120 + r2 * (-1.0 / 5040 + r2 * (1.0 / 362880 + r2 * (-1.0 / 39916800 + r2 * (1.0 / 6227020800.0)))))));
    const double cp = 1.0 + r2 * (-0.5 + r2 * (1.0 / 24 + r2 * (-1.0 / 720 + r2 * (1.0 / 40320 + r2 * (-1.0 / 3628800 + r2 * (1.0 / 479001600 + r2 * (-1.0 / 87178291200.0)))))));
    const int q = ((int)(long long)kq) & 3;
    const double s_ = (q & 1) ? cp : sp, c_ = (q & 1) ? sp : cp;
    sn = (float)((q & 2) ? -s_ : s_); cs = (float)(((q == 1) || (q == 2)) ? -c_ : c_);
}

struct Frame { LAS unsigned char* lds; int tid, lane, wave, vcu, G; };

constexpr int I_GU = 16 * 88, I_D = 44 * 16, I_IN = 16 * 40, I_SQ = 16 * 16, I_KV = 16 * 32, I_LAYER = 2 * I_GU + 2 * I_D + I_IN + 3 * I_SQ + I_KV;
constexpr int IT_GU1 = 0, IT_KV = I_GU, IT_D1 = IT_KV + I_KV, IT_GU2 = IT_D1 + I_D + I_IN + 3 * I_SQ, IT_END = I_LAYER;
__device__ __forceinline__ void convert_items(KArgs ap, const Frame& F, int l, int first, int last, int w, int nw) {
#define a (*ap)
    unsigned char* ws = WSP(a);
    auto decode = [&](int r, TJob& j) {
        unsigned char* wl = ws + WS_W;
        bool sw = false; j.plain = false;
        if (r < I_GU) { j.src = INP(a, 4) + (size_t)l * DMODEL * 2 * DFF; j.K = DMODEL; j.N = 2 * DFF; j.dst = (bf16*)(wl + WO_GU1); j.gain = INP(a, 3) + l * DMODEL; sw = true; }
        else if ((r -= I_GU) < I_KV) { j.src = INP(a, 21) + (size_t)l * DMODEL * 2 * DMODEL; j.K = DMODEL; j.N = 2 * DMODEL; j.dst = (bf16*)(ws + WS_WKV) + (size_t)l * 2048 * 1024; j.gain = INP(a, 19) + l * DMODEL; }
        else if ((r -= I_KV) < I_D) { j.src = INP(a, 5) + (size_t)l * DFF * DMODEL; j.K = DFF; j.N = DMODEL; j.dst = (bf16*)(wl + WO_D1); j.gain = nullptr; }
        else if ((r -= I_D) < I_IN) { j.src = INP(a, 7) + (size_t)l * DMODEL * DIN; j.K = DMODEL; j.N = DIN; j.dst = (bf16*)(wl + WO_IN); j.gain = INP(a, 6) + l * DMODEL; }
        else if ((r -= I_IN) < I_SQ) { j.src = INP(a, 17) + (size_t)l * DMODEL * DMODEL; j.K = DMODEL; j.N = DMODEL; j.dst = (bf16*)(wl + WO_OUT); j.gain = nullptr; }
        else if ((r -= I_SQ) < I_SQ) { j.src = INP(a, 20) + (size_t)l * DMODEL * DMODEL; j.K = DMODEL; j.N = DMODEL; j.dst = (bf16*)(wl + WO_Q); j.gain = INP(a, 18) + l * DMODEL; j.plain = true; }
        else if ((r -= I_SQ) < I_SQ) { j.src = INP(a, 22) + (size_t)l * DMODEL * DMODEL; j.K = DMODEL; j.N = DMODEL; j.dst = (bf16*)(wl + WO_O); j.gain = nullptr; }
        else if ((r -= I_SQ) < I_GU) { j.src = INP(a, 24) + (size_t)l * DMODEL * 2 * DFF; j.K = DMODEL; j.N = 2 * DFF; j.dst = (bf16*)(wl + WO_GU2); j.gain = INP(a, 23) + l * DMODEL; sw = true; }
        else { r -= I_GU; j.src = INP(a, 25) + (size_t)l * DFF * DMODEL; j.K = DFF; j.N = DMODEL; j.dst = (bf16*)(wl + WO_D2); j.gain = nullptr; }
        const int nblk = j.N >> 6, kb = r / nblk, nb = r - kb * nblk; j.k0 = 64 * kb; j.n0 = 64 * nb; j.d0 = j.n0;
        if (sw) { const int half = j.N >> 1, up = (j.n0 >= half) ? 1 : 0, jc = j.n0 - up * half; j.d0 = 256 * (jc >> 7) + 128 * up + (jc & 127); }
    };
    LAS unsigned* T = (LAS unsigned*)(F.lds + RING_OFF + F.wave * 16384); TJob jc, jn; TTile tc, tn; int it = first + w;
    if (it < last) { decode(it, jc); tr_load(jc, tc, F.lane);
        for (;;) { const int nx = it + nw; const bool more = nx < last;
            if (more) { decode(nx, jn); tr_load(jn, tn, F.lane); }
            tr_store(jc, tc, T, F.lane);
            if (!more) break;
            jc = jn; tc = tn; it = nx; } }
#undef a
}
__device__ __forceinline__ void p0_prologue(KArgs ap, const Frame& F) {
#define a (*ap)
    const int gw = F.vcu * NWAVES + F.wave, NGW = F.G * NWAVES;
    unsigned char* ws = WSP(a);
    convert_items(ap, F, 0, IT_GU1, IT_D1, gw, NGW);
    { const float* x = INP(a, 0); bf16* hb = (bf16*)(ws + WS_HB); float* stats = (float*)(ws + WS_STATS);
      for (int m0 = gw; m0 < M; m0 += 4 * NGW) { f32x4 v[4][4];
#pragma unroll
          for (int q = 0; q < 4; ++q) { const int m = m0 + q * NGW; const GAS f32x4* xr = (const GAS f32x4*)(x + (size_t)(m < M ? m : gw) * DMODEL) + F.lane;
#pragma unroll
              for (int j = 0; j < 4; ++j) v[q][j] = xr[64 * j]; }
#pragma unroll
          for (int q = 0; q < 4; ++q) { const int m = m0 + q * NGW; float s = 0.f;
#pragma unroll
              for (int j = 0; j < 4; ++j) s += (v[q][j].x * v[q][j].x + v[q][j].y * v[q][j].y) + (v[q][j].z * v[q][j].z + v[q][j].w * v[q][j].w);
              s = wave_sum(s);
              if (m < M) { GAS unsigned long long* o8 = (GAS unsigned long long*)(hb + (size_t)m * DMODEL) + F.lane;
#pragma unroll
                  for (int j = 0; j < 4; ++j) o8[64 * j] = (unsigned long long)pg8::cvt_pk_bf16(v[q][j].x, v[q][j].y) | ((unsigned long long)pg8::cvt_pk_bf16(v[q][j].z, v[q][j].w) << 32);
                  if (F.lane == 0) *(GAS f32x4*)(stats + (size_t)m * 4) = (f32x4){s, 0.f, 0.f, 0.f}; } } } }
    { const float* mem = INP(a, 1); bf16* mn = (bf16*)(ws + WS_MEMN);
      for (int m = gw; m < BATCH * NMEM; m += NGW) { const GAS f32x4* xr = (const GAS f32x4*)(mem + (size_t)m * DMODEL) + F.lane; f32x4 v[4]; float s = 0.f;
#pragma unroll
          for (int j = 0; j < 4; ++j) { v[j] = xr[64 * j]; s += (v[j].x * v[j].x + v[j].y * v[j].y) + (v[j].z * v[j].z + v[j].w * v[j].w); }
          const float r = 1.0f / sqrtf(wave_sum(s) * (1.0f / DMODEL) + 1e-6f);
          GAS unsigned long long* o8 = (GAS unsigned long long*)(mn + (size_t)m * DMODEL) + F.lane;
#pragma unroll
          for (int j = 0; j < 4; ++j) o8[64 * j] = (unsigned long long)pg8::cvt_pk_bf16(v[j].x * r, v[j].y * r) | ((unsigned long long)pg8::cvt_pk_bf16(v[j].z * r, v[j].w * r) << 32); } }
    { const int* pos = AS1(const int, (const int*)(a).in[2]); float* cs = (float*)(ws + WS_CS);
      const float invf[8] = {1.0f, 0.193922758102417f, 0.03760603070259094f, 0.00729266507551074f, 0.001414213445968926f, 0.00027424818836152554f, 5.318296462064609e-05f, 1.0313385246263351e-05f};
      for (int idx = gw * 64 + F.lane; idx < M * 8; idx += NGW * 64) { const int row = idx >> 3, j = idx & 7;
          float iv = invf[0];
#pragma unroll
          for (int q = 1; q < 8; ++q) iv = (j == q) ? invf[q] : iv;
          const float ang = (float)pos[row] * iv; float sn, c; sincos_d(ang, sn, c); cs[(size_t)row * 16 + j] = c; cs[(size_t)row * 16 + 8 + j] = sn; } }
}

#undef a
__device__ __forceinline__ void gmlp_pair(int cp, int g, const bf16* gu, const bf16* gv, const float* Wl, const float* bsl, const float* lng, const float* lnb, bf16* AG, LAS unsigned char* lds, int wave, int lane) {
    constexpr int VP = 136;
    const int t0 = 16 * wave, fr = lane & 15, fq = lane >> 4;
    const int tl = 16 * wave + (lane >> 2), c0 = (lane & 3) * 32;
    v4u gw4[2][4]; f32x4 lg[8], lb[8]; f32x4 wq[4][2]; unsigned long long gu8[2][8];
#pragma unroll
    for (int ch = 0; ch < 2; ++ch) { const size_t grow = (size_t)(2 * cp + ch) * 128 + tl; const GAS v4u* src = (const GAS v4u*)(gv + grow * 512 + g * 128 + c0);
#pragma unroll
        for (int q = 0; q < 4; ++q) gw4[ch][q] = src[q]; }
#pragma unroll
    for (int q = 0; q < 8; ++q) { lg[q] = *(const GAS f32x4*)(lng + g * 128 + c0 + 4 * q); lb[q] = *(const GAS f32x4*)(lnb + g * 128 + c0 + 4 * q); }
    { const int t = t0 + fr;
#pragma unroll
      for (int ks = 0; ks < 4; ++ks) { const float* wp = Wl + ((size_t)g * 128 + t) * 128 + 32 * ks + 8 * fq; wq[ks][0] = *(const GAS f32x4*)wp; wq[ks][1] = *(const GAS f32x4*)(wp + 4); }
#pragma unroll
      for (int ch = 0; ch < 2; ++ch)
#pragma unroll
          for (int nb = 0; nb < 8; ++nb) gu8[ch][nb] = *(const GAS unsigned long long*)(gu + ((size_t)(2 * cp + ch) * 128 + t) * 512 + g * 128 + 16 * nb + 4 * fq); }
    const float bt = bsl[g * 128 + t0 + fr];
#pragma unroll
    for (int ch = 0; ch < 2; ++ch) { LAS bf16* vnT = (LAS bf16*)(lds + ch * 36864); float v[32];
#pragma unroll
      for (int q = 0; q < 4; ++q) { const v4u w = gw4[ch][q];
#pragma unroll
          for (int e = 0; e < 4; ++e) { const unsigned ww = w[e]; v[q * 8 + 2 * e] = __uint_as_float(ww << 16); v[q * 8 + 2 * e + 1] = __uint_as_float(ww & 0xffff0000u); } }
      float s = 0.f;
#pragma unroll
      for (int i = 0; i < 32; ++i) s += v[i];
      s += __shfl_xor(s, 1); s += __shfl_xor(s, 2);
      const float mean = s * (1.0f / 128.0f); float q2 = 0.f;
#pragma unroll
      for (int i = 0; i < 32; ++i) { v[i] -= mean; q2 += v[i] * v[i]; }
      q2 += __shfl_xor(q2, 1); q2 += __shfl_xor(q2, 2);
      const float rstd = 1.0f / sqrtf(q2 * (1.0f / 128.0f) + 1e-6f);
#pragma unroll
      for (int i = 0; i < 32; i += 2) { const float y0 = v[i] * rstd * lg[i >> 2][i & 3] + lb[i >> 2][i & 3], y1 = v[i + 1] * rstd * lg[(i + 1) >> 2][(i + 1) & 3] + lb[(i + 1) >> 2][(i + 1) & 3];
          const unsigned w = pg8::cvt_pk_bf16(y0, y1); vnT[(c0 + i) * VP + tl] = (bf16)(w & 0xffffu); vnT[(c0 + i + 1) * VP + tl] = (bf16)(w >> 16); } }
    const int nks = (t0 + 15) / 32 + 1;
    bf16x8 wfrag[4];
#pragma unroll
    for (int ks = 0; ks < 4; ++ks) { const int t = t0 + fr, s0 = 32 * ks + 8 * fq;
        float wv[8] = {wq[ks][0].x, wq[ks][0].y, wq[ks][0].z, wq[ks][0].w, wq[ks][1].x, wq[ks][1].y, wq[ks][1].z, wq[ks][1].w};
#pragma unroll
        for (int j = 0; j < 8; ++j) wv[j] = (s0 + j <= t) ? wv[j] : 0.f;
        v4u wf; wf.x = pg8::cvt_pk_bf16(wv[0], wv[1]); wf.y = pg8::cvt_pk_bf16(wv[2], wv[3]); wf.z = pg8::cvt_pk_bf16(wv[4], wv[5]); wf.w = pg8::cvt_pk_bf16(wv[6], wv[7]);
        wfrag[ks] = __builtin_bit_cast(bf16x8, wf); }
    LDS_WAIT(); __syncthreads();
#pragma unroll
    for (int ch = 0; ch < 2; ++ch) { const LAS bf16* vnT = (const LAS bf16*)(lds + ch * 36864);
        f32x4 acc[8];
#pragma unroll
        for (int nb = 0; nb < 8; ++nb) acc[nb] = (f32x4){0.f, 0.f, 0.f, 0.f};
#pragma unroll
        for (int ks = 0; ks < 4; ++ks) if (ks < nks) { const int s0 = 32 * ks + 8 * fq;
#pragma unroll
            for (int nb = 0; nb < 8; ++nb) { const bf16x8 vf = *(const LAS bf16x8*)(vnT + (16 * nb + fr) * VP + s0);
                acc[nb] = __builtin_amdgcn_mfma_f32_16x16x32_bf16(vf, wfrag[ks], acc[nb], 0, 0, 0); } }
        const int t = t0 + fr; const size_t row = (size_t)(2 * cp + ch) * 128 + t;
#pragma unroll
        for (int nb = 0; nb < 8; ++nb) { const int c = 16 * nb + 4 * fq; const unsigned long long gw8 = gu8[ch][nb];
            const unsigned lo = (unsigned)gw8, hi = (unsigned)(gw8 >> 32);
            const float g0 = __uint_as_float(lo << 16), g1 = __uint_as_float(lo & 0xffff0000u), g2 = __uint_as_float(hi << 16), g3 = __uint_as_float(hi & 0xffff0000u);
            const unsigned long long o = (unsigned long long)pg8::cvt_pk_bf16(g0 * (acc[nb][0] + bt), g1 * (acc[nb][1] + bt)) | ((unsigned long long)pg8::cvt_pk_bf16(g2 * (acc[nb][2] + bt), g3 * (acc[nb][3] + bt)) << 32);
            *(GAS unsigned long long*)(AG + row * 1024 + 512 + g * 128 + c) = o; } }
    LDS_WAIT(); __syncthreads();
}
__device__ __forceinline__ void mix2_phase(KArgs ap, const Frame& F, int l_in) {
#define a (*ap)
    int l = l_in; asm volatile("" : "+s"(l));
    unsigned char* ws = WSP(a);
    const bf16* gu = (const bf16*)(ws + WS_R1 + R1_Q + 3 * R1_T); const bf16* gv = (const bf16*)(ws + WS_R1 + R1_Q + 4 * R1_T);
    const bf16* O12 = (const bf16*)(ws + WS_R1 + R1_O12); bf16* AG = (bf16*)(ws + WS_R1 + R1_AG);
    gmlp_pair(F.vcu >> 2, F.vcu & 3, gu, gv, INP(a, 15) + (size_t)l * 4 * 128 * 128, INP(a, 16) + l * 512, INP(a, 13) + l * 512, INP(a, 14) + l * 512, AG, F.lds + RING_OFF, F.wave, F.lane);
    const float li = (l == 0) ? 0.2f : 0.35550906759096934f;
    const float s1 = wave_sum(INP(a, 8)[l * 64 + F.lane] * INP(a, 9)[l * 64 + F.lane]), s2 = wave_sum(INP(a, 10)[l * 64 + F.lane] * INP(a, 11)[l * 64 + F.lane]);
    const float lam = __expf(s1) - __expf(s2) + li;
    const float* sub = INP(a, 12) + l * 128 + (F.lane & 15) * 8; float sg[8];
#pragma unroll
    for (int e = 0; e < 8; ++e) sg[e] = sub[e] * (1.0f - li);
    const int gw = F.vcu * NWAVES + F.wave, NGW = F.G * NWAVES;
    for (int m0 = gw; m0 < M; m0 += 8 * NGW) { v4u w1[8], w2[8];
#pragma unroll
        for (int q = 0; q < 8; ++q) { const int m = m0 + q * NGW, mm = m < M ? m : gw; w1[q] = *(const GAS v4u*)(O12 + (size_t)mm * 1024 + F.lane * 8); w2[q] = *(const GAS v4u*)(O12 + (size_t)mm * 1024 + 512 + F.lane * 8); }
#pragma unroll
        for (int q = 0; q < 8; ++q) { const int m = m0 + q * NGW; float d[8]; float ss = 0.f;
#pragma unroll
            for (int e = 0; e < 4; ++e) { const float a0 = __uint_as_float(w1[q][e] << 16), a1 = __uint_as_float(w1[q][e] & 0xffff0000u), b0 = __uint_as_float(w2[q][e] << 16), b1 = __uint_as_float(w2[q][e] & 0xffff0000u);
                d[2 * e] = a0 - lam * b0; d[2 * e + 1] = a1 - lam * b1; ss += d[2 * e] * d[2 * e] + d[2 * e + 1] * d[2 * e + 1]; }
            ss += __shfl_xor(ss, 1); ss += __shfl_xor(ss, 2); ss += __shfl_xor(ss, 4); ss += __shfl_xor(ss, 8);
            const float r = 1.0f / sqrtf(ss * (1.0f / 128.0f) + 1e-6f);
            v4u o; o.x = pg8::cvt_pk_bf16(d[0] * r * sg[0], d[1] * r * sg[1]); o.y = pg8::cvt_pk_bf16(d[2] * r * sg[2], d[3] * r * sg[3]); o.z = pg8::cvt_pk_bf16(d[4] * r * sg[4], d[5] * r * sg[5]); o.w = pg8::cvt_pk_bf16(d[6] * r * sg[6], d[7] * r * sg[7]);
            if (m < M) *(GAS v4u*)(AG + (size_t)m * 1024 + F.lane * 8) = o; }
    }
}
#undef a
#undef a
#define KA() ({ KArgs p_ = (KArgs)__builtin_amdgcn_kernarg_segment_ptr(); asm volatile("" : "+s"(p_)); p_; })
__device__ __forceinline__ Frame make_frame(LAS unsigned char* l) {
    Frame F; F.lds = l; int t_ = threadIdx.x; asm volatile("" : "+v"(t_)); F.tid = t_; F.lane = F.tid & 63; int w_ = __builtin_amdgcn_readfirstlane(F.tid >> 6); asm volatile("" : "+s"(w_)); F.wave = w_;
    F.G = gridDim.x; { const int bx = blockIdx.x; F.vcu = (F.G % 8 == 0) ? (bx % 8) * (F.G / 8) + bx / 8 : bx; } return F;
}
__global__ void __launch_bounds__(NWAVES * 64, 2) hybrid_fwd(Args args_unused) {
    extern __shared__ __attribute__((aligned(16))) unsigned char lds[];
    LAS unsigned char* const L = (LAS unsigned char*)lds;
    for (int u = threadIdx.x; u < (LDS_BYTES - LDSCTL_OFF) / 4; u += NWAVES * 64) ((LAS unsigned*)(L + LDSCTL_OFF))[u] = 0u;
    __syncthreads();
    XcdBarrier bar = xcd_barrier_post((unsigned*)((gu32*)(WSP(*KA()) + WS_CTL) + CW_BAR), (volatile LAS unsigned*)(L + MISC_OFF) + 8);
#define GRID_BAR() xcd_barrier(bar)
#if REPMASK
    for (int rep = 0; rep < (((REPMASK >> 12) & 1) ? 2 : 1); ++rep)
#endif
    { { KArgs a = KA(); const Frame F = make_frame(L); p0_prologue(a, F); }
    GRID_BAR(); }

#pragma nounroll
    for (int l = 0; l < DEPTH; ++l) {
#pragma nounroll
        for (int s = 0; s < 10; ++s) {
#if REPMASK
            for (int rep = 0; rep < (((REPMASK >> s) & 1) ? 2 : 1); ++rep) {
#else
            { const int rep = 0;
#endif
            KArgs a = KA(); unsigned char* ws = WSP(*a); unsigned char* r1 = ws + WS_R1; const unsigned char* wl = ws + WS_W;
            int bid_ = (int)blockIdx.x, G_ = (int)gridDim.x; asm volatile("" : "+s"(bid_), "+s"(G_));
            const int bid = bid_, G = G_;
            if (s == 0 || s == 8) {
                pg8::Gemm g = pg8::make_gemm((const bf16*)(ws + WS_HB), (const bf16*)(wl + (s == 0 ? WO_GU1 : WO_GU2)), DMODEL); pg8::StaticOrder S; S.init(M, 2 * DFF, G, bid);
                pg8::EpiSwiGLU E{(bf16*)(r1 + R1_HMID), DFF, (const float*)(ws + WS_STATS)};
                pg8::gemm_phase<pg8::EpiSwiGLU, pg8::StaticOrder, true, true>(L + RING_OFF, g, S, E);
                if (s == 0) {
                    if (l == 0) {
                        pg8::Gemm gk = pg8::make_gemm((const bf16*)(ws + WS_MEMN), (const bf16*)(ws + WS_WKV), DMODEL); pg8::KvOrder SK{bid - 128, 0};
                        pg8::EpiKV EK{(bf16*)(ws + WS_KC), (size_t)((WS_VC - WS_KC) / 2)};
                        pg8::gemm_phase<pg8::EpiKV, pg8::KvOrder, true, true>(L + RING_OFF, gk, SK, EK);
                        if (bid >= 144) { const Frame F = make_frame(L); convert_items(a, F, 0, IT_D1, IT_GU2, (bid - 144) * NWAVES + F.wave, 112 * NWAVES); }
                    } else if (bid >= 192) { const Frame F = make_frame(L); convert_items(a, F, 1, IT_GU2, IT_END, (bid - 192) * NWAVES + F.wave, 64 * NWAVES); }
                } else if (l == 0) {
                    pg8::Gemm gk = pg8::make_gemm((const bf16*)(ws + WS_MEMN), (const bf16*)(ws + WS_WKV), DMODEL); pg8::KvOrder SK{bid - 128, 1};
                    pg8::EpiKV EK{(bf16*)(ws + WS_KC), (size_t)((WS_VC - WS_KC) / 2)};
                    pg8::gemm_phase<pg8::EpiKV, pg8::KvOrder, true, true>(L + RING_OFF, gk, SK, EK);
                    if (bid >= 144) { const Frame F = make_frame(L); const int w = (bid - 144) * NWAVES + F.wave, nw = 112 * NWAVES;
                        convert_items(a, F, 1, IT_GU1, IT_KV, w, nw); convert_items(a, F, 1, IT_D1, IT_GU2, w, nw); }
                }
                if ((s == 0 && l == 1)) {
#define FOLD_UNITS(LAYER) do { \
                    { pg8::Gemm gq; gq.A = (const bf16*)(ws + WS_KC) + (size_t)(LAYER) * 512 * 1024; gq.Bt = (const bf16*)(wl + WO_Q); gq.lda = 1024; gq.ldb = 1024; gq.K = 256; gq.ash = 2; gq.bsh = 2; \
                      gq.a_hi = 256 * 1024; gq.a_lo = 256; gq.a_pn = 0; gq.b_hi = 0; gq.b_lo = 256; gq.b_pn = 256 * 1024; pg8::PreOrder SQ{bid - 128}; \
                      pg8::EpiRowBf16 EQ{(bf16*)(ws + WS_X1) + (size_t)(LAYER) * 2 * 1024 * 1024, 1024, nullptr, C2_CROSS}; \
                      pg8::gemm_phase<pg8::EpiRowBf16, pg8::PreOrder, true, true>(L + RING_OFF, gq, SQ, EQ); } \
                    { pg8::Gemm gv; gv.A = (const bf16*)(wl + WO_O); gv.Bt = (const bf16*)(ws + WS_VC) + (size_t)(LAYER) * 512 * 1024; gv.lda = 1024; gv.ldb = 1024; gv.K = 256; gv.ash = 2; gv.bsh = 2; \
                      gv.a_hi = 0; gv.a_lo = 256 * 1024; gv.a_pn = 256; gv.b_hi = 256 * 1024; gv.b_lo = 0; gv.b_pn = 256; pg8::PreOrder SV{bid - 160}; \
                      pg8::EpiRowBf16 EV{(bf16*)(ws + WS_X2) + (size_t)(LAYER) * 2 * 1024 * 1024, 1024, nullptr, 1.0f}; \
                      pg8::gemm_phase<pg8::EpiRowBf16, pg8::PreOrder, true, true>(L + RING_OFF, gv, SV, EV); } } while (0)
                    FOLD_UNITS(1);
                }
            } else if (s == 9 && l == DEPTH - 1) {
                pg8::Gemm g = pg8::make_gemm((const bf16*)(r1 + R1_HMID), (const bf16*)(wl + WO_D2), DFF); pg8::StaticOrder S; S.init(M, DMODEL, G, bid);
                pg8::EpiResidFinal E{(const bf16*)(ws + WS_HB), (float*)(ws + WS_STATS), INP(*a, 26), OUTP(*a), (unsigned*)(ws + WS_CTL) + CW_PANEL, 0.5f};
                pg8::gemm_phase<pg8::EpiResidFinal, pg8::StaticOrder, false, true>(L + RING_OFF, g, S, E);
            } else if (s == 1 || s == 9) {
                pg8::Gemm g = pg8::make_gemm((const bf16*)(r1 + R1_HMID), (const bf16*)(wl + (s == 1 ? WO_D1 : WO_D2)), DFF); pg8::StaticOrder S; S.init(M, DMODEL, G, bid);
                pg8::EpiResid E{(const float*)nullptr, (bf16*)(ws + WS_HB), (bf16*)(ws + WS_LO), (float*)(ws + WS_STATS), rep ? 0.0f : 0.5f};
                pg8::gemm_phase<pg8::EpiResid, pg8::StaticOrder, false, true>(L + RING_OFF, g, S, E);
            } else if (s == 5 || s == 7) {
                pg8::Gemm g = pg8::make_gemm((const bf16*)(r1 + (s == 5 ? R1_AG : R1_P)), s == 5 ? (const bf16*)(wl + WO_OUT) : (const bf16*)(ws + WS_X2) + (size_t)l * 2 * 1024 * 1024, DMODEL);
                g.bsh = 5; g.b_hi = (s == 5) ? 0 : 1024 * 1024;
                pg8::StaticOrder S; S.init(M, DMODEL, G, bid);
                pg8::EpiResid E{(const float*)nullptr, (bf16*)(ws + WS_HB), (bf16*)(ws + WS_LO), (float*)(ws + WS_STATS), rep ? 0.0f : 1.0f};
                pg8::gemm_phase<pg8::EpiResid, pg8::StaticOrder, false, true>(L + RING_OFF, g, S, E);
            } else if (s == 2) {
                pg8::Gemm g = pg8::make_gemm((const bf16*)(ws + WS_HB), (const bf16*)(wl + WO_IN), DMODEL); pg8::StaticOrder S; S.init(M, DIN, G, bid, 6);
                pg8::EpiWin E{(bf16*)(r1 + R1_Q), (size_t)(R1_T / 2), (const float*)(ws + WS_STATS), (const float*)(ws + WS_CS), C2_DIFF};
                pg8::gemm_phase<pg8::EpiWin, pg8::StaticOrder, true, true>(L + RING_OFF, g, S, E);
                if (l == 0) {
                    FOLD_UNITS(0);
                    if (bid >= 128) { const Frame F = make_frame(L); const int w = (bid - 128) * NWAVES + F.wave, nw = 128 * NWAVES;
                        convert_items(a, F, 0, IT_GU2, IT_END, w, nw); convert_items(a, F, 1, IT_KV, IT_D1, w, nw); }
                }
            } else if (s == 3) {
                const attn_body::AttnTensors AT{(const attn_body::bf16*)(r1 + R1_Q), (const attn_body::bf16*)(r1 + R1_Q + R1_T), (const attn_body::bf16*)(r1 + R1_Q + 2 * R1_T), (attn_body::bf16*)(r1 + R1_O12)};
                const attn_body::StaticOrder S(G, bid);
                attn_body::attn_phase<attn_body::StaticOrder>((char*)lds + RING_OFF, AT, S);
            } else if (s == 4) {
                const Frame F = make_frame(L); mix2_phase(a, F, l);
            } else if (s == 6) {
                pg8::Gemm g = pg8::make_gemm((const bf16*)(ws + WS_HB), (const bf16*)(ws + WS_X1) + (size_t)l * 2 * 1024 * 1024, DMODEL); g.bsh = 5; g.b_hi = 1024 * 1024;
                pg8::StaticOrder S; S.init(M, DMODEL, G, bid);
                pg8::EpiScores E{(bf16*)(r1 + R1_P), (const float*)(ws + WS_STATS)};
                pg8::gemm_phase<pg8::EpiScores, pg8::StaticOrder, false, true>(L + RING_OFF, g, S, E);
            }
            if (!(s == 9 && l == DEPTH - 1)) GRID_BAR();
            }
        }
    }
#undef GRID_BAR
}

extern "C" void kernel_launch(void* const* d_in, const int* in_sizes, int n_in, void* d_out, int out_size, void* d_ws, size_t ws_size, hipStream_t stream) {
    static int grid = 0;
    if (grid == 0) {
        if (n_in != 27 || in_sizes[0] != M * DMODEL || out_size != M * DMODEL || ws_size < WS_END) { fprintf(stderr, "kernel_launch: unexpected shapes: n_in %d, in0 %d, out %d, ws %zu; nothing launched\n", n_in, n_in > 0 ? in_sizes[0] : -1, out_size, ws_size); grid = -1; return; }
        int dev = 0, cus = 0, per_cu = 0;
        if (hipGetDevice(&dev) != hipSuccess || hipDeviceGetAttribute(&cus, hipDeviceAttributeMultiprocessorCount, dev) != hipSuccess) { fprintf(stderr, "kernel_launch: device query failed\n"); grid = -1; return; }
        if (hipFuncSetAttribute((const void*)hybrid_fwd, hipFuncAttributeMaxDynamicSharedMemorySize, LDS_BYTES) != hipSuccess) { fprintf(stderr, "kernel_launch: hipFuncSetAttribute failed\n"); grid = -1; return; }
        if (hipOccupancyMaxActiveBlocksPerMultiprocessor(&per_cu, (const void*)hybrid_fwd, NWAVES * 64, LDS_BYTES) != hipSuccess || per_cu < 1) { fprintf(stderr, "kernel_launch: occupancy query reports %d workgroups per CU; nothing launched\n", per_cu); (void)hipGetLastError(); grid = -1; return; }
        if (cus < 256) { fprintf(stderr, "kernel_launch: %d CUs; this kernel needs 256 (one workgroup per CU); nothing launched\n", cus); grid = -1; return; }
        grid = 256;
    }
    if (grid < 0) return;
    if (hipMemsetAsync((char*)d_ws + WS_CTL, 0, CTL_ZERO_BYTES, stream) != hipSuccess) { fprintf(stderr, "kernel_launch: hipMemsetAsync failed\n"); return; }
    Args a{};
    for (int i = 0; i < 27; ++i) a.in[i] = (const float*)d_in[i];
    a.out = (float*)d_out; a.ws = (unsigned char*)d_ws;
    hipLaunchKernelGGL(hybrid_fwd, dim3(grid), dim3(NWAVES * 64), LDS_BYTES, stream, a);
    const hipError_t le = hipPeekAtLastError();
    if (le != hipSuccess) fprintf(stderr, "kernel_launch: launch failed: %s\n", hipGetErrorName(le));
}
```

```cpp
#include <hip/hip_runtime.h>
#include <cstdio>
#include <cstdint>
namespace pg8 {
#define PG8_LAS __attribute__((address_space(3)))
typedef unsigned short bf16_t;
typedef short bf16x8 __attribute__((ext_vector_type(8)));
typedef float f32x4 __attribute__((ext_vector_type(4)));
typedef float f32x2 __attribute__((ext_vector_type(2)));
typedef unsigned u32x4 __attribute__((ext_vector_type(4)));
typedef unsigned u32x2 __attribute__((ext_vector_type(2)));
constexpr int BM = 256, BK = 64, HALF = 128, HTB = HALF * BK * 2  , STAGE_BYTES = 9 * HTB, NXCD = 8, WGM = 8;

__host__ __device__ __forceinline__ int lds_byte(int r, int c) { const int st = (r >> 4) * 2 + (c >> 5), rr = r & 15, cc = c & 31, ob = rr * 64 + cc * 2; return st * 1024 + (ob ^ (((ob >> 9) & 1) << 5)); }
__host__ __device__ __forceinline__ void stage_rc(int b, int& R, int& C) { const int st = b / 1024, sb = b % 1024, swz = sb ^ (((sb >> 9) & 1) << 5); R = (st >> 1) * 16 + swz / 64; C = (st & 1) * 32 + (swz % 64) / 2; }
__host__ __device__ __forceinline__ int perm32(int rho) { const int n = rho >> 4, i = rho & 15; return 8 * (i >> 2) + 4 * n + (i & 3); }

struct Unit { int pm, pn; };
struct Gemm { const bf16_t* A; const bf16_t* Bt; int lda, ldb, K; int ash, bsh; long a_hi, a_lo, a_pn, b_hi, b_lo, b_pn; };
__device__ __forceinline__ Gemm make_gemm(const bf16_t* A, const bf16_t* Bt, int K) { Gemm g; g.A = A; g.Bt = Bt; g.lda = K; g.ldb = K; g.K = K; g.ash = 0; g.bsh = 0; g.a_hi = (long)BM * K; g.a_lo = 0; g.a_pn = 0; g.b_hi = 0; g.b_lo = 0; g.b_pn = (long)BM * K; return g; }

struct StaticOrder {
    int nM, nN, nwg, G, c, rot;
    __host__ __device__ void init(int M, int N, int G_, int c_, int rot_ = 0) { nM = M / BM; nN = N / BM; nwg = nM * nN; G = G_; c = c_; rot = rot_; }
    __host__ __device__ bool next(int i, Unit& u) const {
        const long L = (long)i * G + c; if (L >= nwg) return false;
        int wgid = (int)L; { const int q = nwg / NXCD, r = nwg % NXCD, xcd = wgid % NXCD, off = wgid / NXCD; wgid = (xcd < r ? xcd * (q + 1) : r * (q + 1) + (xcd - r) * q) + off; }
        const int nig = WGM * nN, gid = wgid / nig, fm = gid * WGM, gsz = (nM - fm) < WGM ? (nM - fm) : WGM;
        u.pm = fm + ((wgid % nig) % gsz); u.pn = (wgid % nig) / gsz + rot; if (u.pn >= nN) u.pn -= nN; return true;
    }
    __device__ __forceinline__ void a_ready(const Unit&) const {}
    __device__ __forceinline__ void done(const Unit&) const {}
};
struct KvOrder {
    int j, l;
    __device__ __forceinline__ bool next(int i, Unit& u) const { if (i != 0 || j < 0 || j >= 16) return false; u.pm = j & 1; u.pn = 8 * l + (j >> 1); return true; }
    __device__ __forceinline__ void a_ready(const Unit&) const {}
    __device__ __forceinline__ void done(const Unit&) const {}
};
struct PreOrder {
    int j;
    __device__ __forceinline__ bool next(int i, Unit& u) const { if (i != 0 || j < 0 || j >= 32) return false; u.pm = j >> 2; u.pn = j & 3; return true; }
    __device__ __forceinline__ void a_ready(const Unit&) const {}
    __device__ __forceinline__ void done(const Unit&) const {}
};

__device__ __forceinline__ unsigned cvt_pk_bf16(float lo, float hi) { unsigned r; asm volatile("v_cvt_pk_bf16_f32 %0, %1, %2" : "=v"(r) : "v"(lo), "v"(hi)); return r; }
__device__ __forceinline__ f32x2 gelu_pk(f32x2 v) {
    const f32x2 av = __builtin_elementwise_abs(v), d = av * 0.2316418882f + 1.0f;
    f32x2 t; t.x = __builtin_amdgcn_rcpf(d.x); t.y = __builtin_amdgcn_rcpf(d.y);
    f32x2 q = t * 0.5307027145f + (-0.7265760135f); q = q * t + 0.7107068705f; q = q * t + (-0.142248368f); q = q * t + 0.127414796f; q = q * t;
    const f32x2 s = (v * v) * (-0.72134752044f);
    f32x2 e; e.x = __builtin_amdgcn_exp2f(s.x); e.y = __builtin_amdgcn_exp2f(s.y);
    const f32x2 m = v * (q * e), r = v - m;
    f32x2 o; o.x = v.x < 0.f ? m.x : r.x; o.y = v.y < 0.f ? m.y : r.y; return o;
}
__device__ __forceinline__ f32x4 gelu4(f32x4 v) { const f32x2 a = gelu_pk((f32x2){v[0], v[1]}), b = gelu_pk((f32x2){v[2], v[3]}); return (f32x4){a.x, a.y, b.x, b.y}; }
__device__ __forceinline__ float silu1(float g) { return g * __builtin_amdgcn_rcpf(1.0f + __builtin_amdgcn_exp2f(g * -1.4426950408889634f)); }
__device__ __forceinline__ float rs_from_stats(const float* stats, int row) { const f32x4 s = *(const f32x4*)(stats + (size_t)row * 4); return __builtin_amdgcn_rsqf(((s[0] + s[1]) + (s[2] + s[3])) * (1.0f / 1024.0f) + 1e-6f); }

__host__ __device__ constexpr int resid_buf(int j) { return j == 3 ? 8 : j; }
__host__ __device__ constexpr int resid_lds(int p) { return resid_buf(p >> 1) * HTB + (p & 1) * 8192; }
constexpr int RESID_P_OFF = 9 * HTB + 1024;

__device__ __forceinline__ void st16_wt(void* p, u32x4 v) { asm volatile("global_store_dwordx4 %0, %1, off sc1\n\ts_nop 1" :: "v"(p), "v"(v) : "memory"); }


struct EpiSwiGLU {
    static constexpr bool PERM = true, AFTER_DRAIN = false;
    bf16_t* O; int ldc; const float* stats;
    __device__ __forceinline__ void operator()(const f32x4 (&acc)[2][2][4][2], const Unit& u, int wr, int wc, int fr, int fq) const {
        const int row0 = u.pm * BM + wr * 64 + fr, col0 = u.pn * HALF + wc * 32 + 8 * fq;
#pragma unroll
        for (int ai = 0; ai < 2; ++ai)
#pragma unroll
            for (int m = 0; m < 4; ++m) { const int row = row0 + ai * HALF + m * 16; const float r = rs_from_stats(stats, row); const float c = r * -1.4426950408889634f, r2 = r * r;
                u32x4 w; unsigned ww[4];
#pragma unroll
                for (int n = 0; n < 2; ++n) {
                    const f32x4 g = acc[ai][0][m][n], up = acc[ai][1][m][n]; const f32x4 t = (g * up) * r2, ea = g * c; f32x4 e, s;
#pragma unroll
                    for (int i = 0; i < 4; ++i) e[i] = __builtin_amdgcn_exp2f(ea[i]);
                    e = e + 1.0f;
#pragma unroll
                    for (int i = 0; i < 4; ++i) s[i] = __builtin_amdgcn_rcpf(e[i]);
                    const f32x4 o = t * s; ww[2 * n] = cvt_pk_bf16(o[0], o[1]); ww[2 * n + 1] = cvt_pk_bf16(o[2], o[3]); }
                w.x = ww[0]; w.y = ww[1]; w.z = ww[2]; w.w = ww[3];
                *(u32x4*)(O + (size_t)row * ldc + col0) = w; }
    }
};

struct EpiWin {
    static constexpr bool PERM = true, AFTER_DRAIN = false;
    bf16_t* O5; size_t ostride; const float* stats; const float* cs; float qscale;
    __device__ __forceinline__ void operator()(const f32x4 (&acc)[2][2][4][2], const Unit& u, int wr, int wc, int fr, int fq) const {
        const int typ = u.pn >> 1; bf16_t* base = O5 + (size_t)typ * ostride;
        const int row0 = u.pm * BM + wr * 64 + fr, col0 = (u.pn & 1) * BM + wc * 32 + 8 * fq;
        const bool rot = (typ < 2) && ((wc & 1) == 0);
        const float sgn = (fq == 0) ? -1.0f : 1.0f; const bool rl = fq < 2; const float qs = (typ == 0) ? qscale : 1.0f;
#pragma unroll
        for (int ai = 0; ai < 2; ++ai)
#pragma unroll
            for (int m = 0; m < 4; ++m) { const int row = row0 + ai * HALF + m * 16; const float r = rs_from_stats(stats, row);
                f32x4 cc[2], sn[2];
                if (rot) { cc[0] = *(const f32x4*)(cs + (size_t)row * 16); cc[1] = *(const f32x4*)(cs + (size_t)row * 16 + 4); sn[0] = *(const f32x4*)(cs + (size_t)row * 16 + 8); sn[1] = *(const f32x4*)(cs + (size_t)row * 16 + 12); }
#pragma unroll
                for (int bj = 0; bj < 2; ++bj) { f32x4 v0 = acc[ai][bj][m][0] * r, v1 = acc[ai][bj][m][1] * r;
                    if (rot) {
                        f32x4 p0, p1;
#pragma unroll
                        for (int i = 0; i < 4; ++i) { p0[i] = __shfl_xor(v0[i], 16); p1[i] = __shfl_xor(v1[i], 16); }
                        const f32x4 n0 = v0 * cc[0] + (p0 * sn[0]) * sgn, n1 = v1 * cc[1] + (p1 * sn[1]) * sgn;
                        if (rl) { v0 = n0; v1 = n1; }
                    }
                    if (typ >= 3) { v0 = gelu4(v0); v1 = gelu4(v1); }
                    v0 = v0 * qs; v1 = v1 * qs;
                    u32x4 w; w.x = cvt_pk_bf16(v0[0], v0[1]); w.y = cvt_pk_bf16(v0[2], v0[3]); w.z = cvt_pk_bf16(v1[0], v1[1]); w.w = cvt_pk_bf16(v1[2], v1[3]);
                    *(u32x4*)(base + (size_t)row * 512 + col0 + bj * HALF) = w; } }
    }
};

struct EpiRowBf16 {
    static constexpr bool PERM = true, AFTER_DRAIN = false;
    bf16_t* O; int ldc; const float* stats; float sc;
    __device__ __forceinline__ void operator()(const f32x4 (&acc)[2][2][4][2], const Unit& u, int wr, int wc, int fr, int fq) const {
        const int row0 = u.pm * BM + wr * 64 + fr, col0 = u.pn * BM + wc * 32 + 8 * fq;
#pragma unroll
        for (int ai = 0; ai < 2; ++ai)
#pragma unroll
            for (int m = 0; m < 4; ++m) { const int row = row0 + ai * HALF + m * 16; const float r = (stats ? rs_from_stats(stats, row) : 1.0f) * sc;
#pragma unroll
                for (int bj = 0; bj < 2; ++bj) { const f32x4 v0 = acc[ai][bj][m][0] * r, v1 = acc[ai][bj][m][1] * r;
                    u32x4 w; w.x = cvt_pk_bf16(v0[0], v0[1]); w.y = cvt_pk_bf16(v0[2], v0[3]); w.z = cvt_pk_bf16(v1[0], v1[1]); w.w = cvt_pk_bf16(v1[2], v1[3]);
                    *(u32x4*)(O + (size_t)row * ldc + col0 + bj * HALF) = w; } }
    }
};

struct EpiKV {
    static constexpr bool PERM = true, AFTER_DRAIN = false;
    bf16_t* Kc; size_t vc_off;
    __device__ __forceinline__ void operator()(const f32x4 (&acc)[2][2][4][2], const Unit& u, int wr, int wc, int fr, int fq) const {
        const int layer = u.pn >> 3, t = u.pn & 7;
        const int row0 = u.pm * BM + wr * 64 + fr;
        bf16_t* base = Kc + (size_t)(t >> 2) * vc_off + (size_t)layer * 512 * 1024; const int col0 = (t & 3) * BM + wc * 32 + 8 * fq;
#pragma unroll
        for (int ai = 0; ai < 2; ++ai)
#pragma unroll
            for (int m = 0; m < 4; ++m) { const int row = row0 + ai * HALF + m * 16;
#pragma unroll
                for (int bj = 0; bj < 2; ++bj) { const f32x4 v0 = acc[ai][bj][m][0], v1 = acc[ai][bj][m][1];
                    u32x4 w; w.x = cvt_pk_bf16(v0[0], v0[1]); w.y = cvt_pk_bf16(v0[2], v0[3]); w.z = cvt_pk_bf16(v1[0], v1[1]); w.w = cvt_pk_bf16(v1[2], v1[3]);
                    *(u32x4*)(base + (size_t)row * 1024 + col0 + bj * HALF) = w; } }
    }
};

__device__ __forceinline__ float bflo(unsigned w) { return __uint_as_float(w << 16); }
__device__ __forceinline__ float bfhi(unsigned w) { return __uint_as_float(w & 0xffff0000u); }
struct EpiResid {
    static constexpr bool PERM = true, AFTER_DRAIN = true, RESID_LDS = true;
    const float* xin; bf16_t* hb; bf16_t* lo; float* stats; float alpha;
    __device__ __forceinline__ void fused(f32x4 (&acc)[2][2][4][2], const Unit& u, int wr, int wc, int fr, int fq, PG8_LAS unsigned char* lds, int wid, int lane) const {
        PG8_LAS float* P = (PG8_LAS float*)(lds + RESID_P_OFF);
        const int col0 = u.pn * BM + wc * 32 + 8 * fq;
        const size_t off0 = (size_t)(u.pm * BM + wr * 64 + fr) * 1024 + col0;
#define RES_STEP(AI, M_, BJ, H) do { u32x4 hw; \
            _Pragma("unroll") for (int e = 0; e < 4; ++e) { const float o0 = (H)[2 * e] + acc[AI][BJ][M_][e >> 1][(2 * e) & 3] * alpha, o1 = (H)[2 * e + 1] + acc[AI][BJ][M_][e >> 1][(2 * e + 1) & 3] * alpha; \
                hw[e] = cvt_pk_bf16(o0, o1); ss += o0 * o0 + o1 * o1; } \
            st16_wt(hb + off0 + (size_t)((AI) * HALF + (M_) * 16) * 1024 + (BJ) * HALF, hw); } while (0)
        if (xin) {
#pragma unroll
            for (int ai = 0; ai < 2; ++ai)
#pragma unroll
                for (int m = 0; m < 4; ++m) { float ss = 0.f;
#pragma unroll
                    for (int bj = 0; bj < 2; ++bj) { const size_t o8 = off0 + (size_t)(ai * HALF + m * 16) * 1024 + bj * HALF; const f32x4 a = *(const f32x4*)(xin + o8), b = *(const f32x4*)(xin + o8 + 4);
                        const float h[8] = {a[0], a[1], a[2], a[3], b[0], b[1], b[2], b[3]}; RES_STEP(ai, m, bj, h); }
                    ss += __shfl_xor(ss, 16); ss += __shfl_xor(ss, 32);
                    if (fq == 0) P[(ai * HALF + wr * 64 + m * 16 + fr) * 4 + wc] = ss;
                    if (m & 1) asm volatile("" ::: "memory"); }
        } else {
            u32x4 hv[2][4][2];
#pragma unroll
            for (int ai = 0; ai < 2; ++ai)
#pragma unroll
                for (int m = 0; m < 4; ++m)
#pragma unroll
                    for (int bj = 0; bj < 2; ++bj) hv[ai][m][bj] = *(const PG8_LAS u32x4*)(lds + resid_lds(ai * 8 + m * 2 + bj) + wid * 1024 + lane * 16);
#pragma unroll
            for (int ai = 0; ai < 2; ++ai)
#pragma unroll
                for (int m = 0; m < 4; ++m) { float ss = 0.f;
#pragma unroll
                    for (int bj = 0; bj < 2; ++bj) { const u32x4 w4 = hv[ai][m][bj];
                        const float h[8] = {bflo(w4[0]), bfhi(w4[0]), bflo(w4[1]), bfhi(w4[1]), bflo(w4[2]), bfhi(w4[2]), bflo(w4[3]), bfhi(w4[3])}; RES_STEP(ai, m, bj, h); }
                    ss += __shfl_xor(ss, 16); ss += __shfl_xor(ss, 32);
                    if (fq == 0) P[(ai * HALF + wr * 64 + m * 16 + fr) * 4 + wc] = ss; }
        }
#undef RES_STEP
        asm volatile("s_waitcnt lgkmcnt(0)" ::: "memory"); __builtin_amdgcn_s_barrier(); asm volatile("" ::: "memory");
        const int tid = wid * 64 + lane;
        if (tid < 256) { const f32x4 p = *(const PG8_LAS f32x4*)(P + tid * 4); stats[(size_t)(u.pm * BM + tid) * 4 + u.pn] = (p[0] + p[1]) + (p[2] + p[3]); }
        asm volatile("s_waitcnt lgkmcnt(0)" ::: "memory"); __builtin_amdgcn_s_barrier(); asm volatile("" ::: "memory");
    }
};

struct EpiResidFinal {
    static constexpr bool PERM = true, AFTER_DRAIN = true, RESID_LDS = true;
    const bf16_t* hb; float* stats; const float* gain; float* out; unsigned* cnt; float alpha;
    __device__ __forceinline__ void fused(f32x4 (&acc)[2][2][4][2], const Unit& u, int wr, int wc, int fr, int fq, PG8_LAS unsigned char* lds, int wid, int lane) const {
        PG8_LAS float* P = (PG8_LAS float*)(lds + RESID_P_OFF);
        const int col0 = u.pn * BM + wc * 32 + 8 * fq;
        const size_t off0 = (size_t)(u.pm * BM + wr * 64 + fr) * 1024 + col0;
        { u32x4 hv[2][4][2];
#pragma unroll
          for (int ai = 0; ai < 2; ++ai)
#pragma unroll
              for (int m = 0; m < 4; ++m)
#pragma unroll
                  for (int bj = 0; bj < 2; ++bj) hv[ai][m][bj] = *(const PG8_LAS u32x4*)(lds + resid_lds(ai * 8 + m * 2 + bj) + wid * 1024 + lane * 16);
#pragma unroll
          for (int ai = 0; ai < 2; ++ai)
#pragma unroll
              for (int m = 0; m < 4; ++m) { float ss = 0.f;
#pragma unroll
                  for (int bj = 0; bj < 2; ++bj) { const u32x4 w4 = hv[ai][m][bj];
#pragma unroll
                      for (int n = 0; n < 2; ++n) { f32x4 o = acc[ai][bj][m][n] * alpha;
                          o[0] += bflo(w4[2 * n]); o[1] += bfhi(w4[2 * n]); o[2] += bflo(w4[2 * n + 1]); o[3] += bfhi(w4[2 * n + 1]);
                          ss += (o[0] * o[0] + o[1] * o[1]) + (o[2] * o[2] + o[3] * o[3]); acc[ai][bj][m][n] = o; } }
                  ss += __shfl_xor(ss, 16); ss += __shfl_xor(ss, 32);
                  if (fq == 0) P[(ai * HALF + wr * 64 + m * 16 + fr) * 4 + wc] = ss; } }
        asm volatile("s_waitcnt lgkmcnt(0)" ::: "memory"); __builtin_amdgcn_s_barrier(); asm volatile("" ::: "memory");
        const int tid = wid * 64 + lane;
        if (tid < 256) { const f32x4 p = *(const PG8_LAS f32x4*)(P + tid * 4); stats[(size_t)(u.pm * BM + tid) * 4 + u.pn] = (p[0] + p[1]) + (p[2] + p[3]); }
        asm volatile("s_waitcnt vmcnt(0) lgkmcnt(0)" ::: "memory"); __builtin_amdgcn_s_barrier(); asm volatile("" ::: "memory");
        if (tid == 0) { unsigned* c = cnt + u.pm * 16;
            __builtin_amdgcn_fence(__ATOMIC_RELEASE, "agent"); asm volatile("s_waitcnt vmcnt(0)" ::: "memory");
            (void)__hip_atomic_fetch_add(c, 1u, __ATOMIC_RELAXED, __HIP_MEMORY_SCOPE_AGENT);
            unsigned sp = 0u; while (__hip_atomic_load(c, __ATOMIC_RELAXED, __HIP_MEMORY_SCOPE_AGENT) < 4u && ++sp < (1u << 22)) __builtin_amdgcn_s_sleep(1);
            __builtin_amdgcn_fence(__ATOMIC_ACQUIRE, "agent"); asm volatile("s_waitcnt vmcnt(0)" ::: "memory"); }
        __builtin_amdgcn_s_barrier(); asm volatile("" ::: "memory");
        f32x4 g4[2][2];
#pragma unroll
        for (int bj = 0; bj < 2; ++bj)
#pragma unroll
            for (int n = 0; n < 2; ++n) g4[bj][n] = *(const f32x4*)(gain + col0 + bj * HALF + 4 * n);
#pragma unroll
        for (int ai = 0; ai < 2; ++ai)
#pragma unroll
            for (int m = 0; m < 4; ++m) { const int row = u.pm * BM + ai * HALF + wr * 64 + m * 16 + fr; const float r = rs_from_stats(stats, row);
#pragma unroll
                for (int bj = 0; bj < 2; ++bj)
#pragma unroll
                    for (int n = 0; n < 2; ++n) *(f32x4*)(out + (size_t)row * 1024 + col0 + bj * HALF + 4 * n) = acc[ai][bj][m][n] * r * g4[bj][n]; }
    }
};

struct EpiScores {
    static constexpr bool PERM = true, AFTER_DRAIN = true, RESID_LDS = false;
    bf16_t* Pm; const float* stats;
    __device__ __forceinline__ void fused(f32x4 (&acc)[2][2][4][2], const Unit& u, int wr, int wc, int fr, int fq, PG8_LAS unsigned char* lds, int wid, int lane) const {
        PG8_LAS f32x2* PX = (PG8_LAS f32x2*)lds;
        float mw[2][4];
#pragma unroll
        for (int ai = 0; ai < 2; ++ai)
#pragma unroll
            for (int m = 0; m < 4; ++m) { const int rl = ai * HALF + wr * 64 + m * 16 + fr; float a = -3.0e38f; const float rs = rs_from_stats(stats, u.pm * BM + rl);
#pragma unroll
                for (int bj = 0; bj < 2; ++bj)
#pragma unroll
                    for (int n = 0; n < 2; ++n) { const f32x4 x = acc[ai][bj][m][n] * rs; acc[ai][bj][m][n] = x; a = fmaxf(a, fmaxf(fmaxf(x[0], x[1]), fmaxf(x[2], x[3]))); }
                a = fmaxf(a, __shfl_xor(a, 16)); a = fmaxf(a, __shfl_xor(a, 32)); mw[ai][m] = a; float s = 0.f;
#pragma unroll
                for (int bj = 0; bj < 2; ++bj)
#pragma unroll
                    for (int n = 0; n < 2; ++n) { f32x4 x = acc[ai][bj][m][n];
#pragma unroll
                        for (int i = 0; i < 4; ++i) { x[i] = __builtin_amdgcn_exp2f(x[i] - a); s += x[i]; }
                        acc[ai][bj][m][n] = x; }
                s += __shfl_xor(s, 16); s += __shfl_xor(s, 32);
                if (fq == 0) PX[rl * 4 + wc] = (f32x2){a, s}; }
        asm volatile("s_waitcnt lgkmcnt(0)" ::: "memory"); __builtin_amdgcn_s_barrier(); asm volatile("" ::: "memory");
        const int col0 = u.pn * BM + wc * 32 + 8 * fq;
#pragma unroll
        for (int ai = 0; ai < 2; ++ai)
#pragma unroll
            for (int m = 0; m < 4; ++m) { const int rl = ai * HALF + wr * 64 + m * 16 + fr;
                const f32x4 p01 = *(const PG8_LAS f32x4*)(PX + rl * 4), p23 = *(const PG8_LAS f32x4*)(PX + rl * 4 + 2);
                const float mrow = fmaxf(fmaxf(p01[0], p01[2]), fmaxf(p23[0], p23[2]));
                const float l = (p01[1] * __builtin_amdgcn_exp2f(p01[0] - mrow) + p01[3] * __builtin_amdgcn_exp2f(p01[2] - mrow)) + (p23[1] * __builtin_amdgcn_exp2f(p23[0] - mrow) + p23[3] * __builtin_amdgcn_exp2f(p23[2] - mrow));
                const float inv = __builtin_amdgcn_exp2f(mw[ai][m] - mrow) * __builtin_amdgcn_rcpf(l);
#pragma unroll
                for (int bj = 0; bj < 2; ++bj) { const f32x4 v0 = acc[ai][bj][m][0] * inv, v1 = acc[ai][bj][m][1] * inv;
                    u32x4 w; w.x = cvt_pk_bf16(v0[0], v0[1]); w.y = cvt_pk_bf16(v0[2], v0[3]); w.z = cvt_pk_bf16(v1[0], v1[1]); w.w = cvt_pk_bf16(v1[2], v1[3]);
                    st16_wt(Pm + (size_t)(u.pm * BM + rl) * 1024 + col0 + bj * HALF, w); } }
        asm volatile("s_waitcnt lgkmcnt(0)" ::: "memory"); __builtin_amdgcn_s_barrier(); asm volatile("" ::: "memory");
    }
};

template <class Epi, class Sched, bool ALIGN_EPI = false, bool SP2 = false>
__device__ __forceinline__ void gemm_phase(PG8_LAS unsigned char* lds, const Gemm g, const Sched& S, const Epi& E) {
    int tid_ = threadIdx.x; asm volatile("" : "+v"(tid_));
    int wid_ = __builtin_amdgcn_readfirstlane(tid_ >> 6); asm volatile("" : "+s"(wid_));
    const int tid = tid_, wid = wid_, lane = tid & 63, wr = wid >> 2, wc = wid & 3, fr = lane & 15, fq = lane >> 4;
    constexpr bool RL = []{ if constexpr (Epi::AFTER_DRAIN) return Epi::RESID_LDS; else return false; }();
    const int K = g.K, nt = K / BK;
    unsigned voffA[2], voffB[2];
#pragma unroll
    for (int i = 0; i < 2; ++i) { int R, C; stage_rc(tid * 16 + i * 8192, R, C); const int Rb = Epi::PERM ? ((R & ~31) + perm32(R & 31)) : R;
        voffA[i] = (unsigned)(R * g.lda + C) * 2u; voffB[i] = (unsigned)(Rb * g.ldb + C) * 2u; }
    const size_t kstep = (size_t)(BK * 2);
    const size_t hstepA = (size_t)HALF * g.lda * 2, hstepB = (size_t)HALF * g.ldb * 2;
    const unsigned ldsw = (unsigned)wid * 1024u;
    const int aoff = lds_byte(wr * 64 + fr, fq * 8), boff = lds_byte(wc * 32 + fr, fq * 8);
#define PG8_ABASE(u) ((const char*)(g.A + ((size_t)((u).pm >> g.ash) * g.a_hi + (size_t)((u).pm & ((1 << g.ash) - 1)) * g.a_lo + (size_t)(u).pn * g.a_pn)))
#define PG8_BBASE(u) ((const char*)(g.Bt + ((size_t)((u).pm >> g.bsh) * g.b_hi + (size_t)((u).pm & ((1 << g.bsh) - 1)) * g.b_lo + (size_t)(u).pn * g.b_pn)))
#define PG8_SA(b, h) (((b) * 2 + (h)) * HTB)
#define PG8_SB(b, h) ((4 + (b) * 2 + (h)) * HTB)
#define PG8_STAGE(bufoff, gbase, voff) do { _Pragma("unroll") for (int _i = 0; _i < 2; ++_i) \
        __builtin_amdgcn_global_load_lds((const unsigned*)((const char*)(gbase) + (voff)[_i]), (PG8_LAS unsigned*)(lds + (bufoff) + ldsw + _i * 8192), 16, 0, 0); } while (0)
#define PG8_STAGE_R(j) do { if constexpr (RL) { int t_ = threadIdx.x; asm volatile("" : "+v"(t_)); const int l_ = t_ & 63, w_ = __builtin_amdgcn_readfirstlane(t_ >> 6); \
        const unsigned lo_ = (unsigned)(((w_ >> 2) * 64 + (l_ & 15)) * 1024 + (w_ & 3) * 32 + 8 * (l_ >> 4)) * 2u; \
        const char* rb_ = (const char*)(E.hb + ((size_t)(cur.pm * BM) * 1024 + cur.pn * BM)); \
        _Pragma("unroll") for (int _i = 0; _i < 2; ++_i) { const int p_ = 2 * (j) + _i; \
            __builtin_amdgcn_global_load_lds((const unsigned*)(rb_ + ((size_t)((p_ >> 3) * HALF + ((p_ >> 1) & 3) * 16) * 1024 + (p_ & 1) * HALF) * 2 + lo_), (PG8_LAS unsigned*)(lds + resid_buf(j) * HTB + ldsw + _i * 8192), 16, 0, 0); } } } while (0)
#define PG8_LDA(dst, b, h) do { _Pragma("unroll") for (int m = 0; m < 4; ++m) _Pragma("unroll") for (int k = 0; k < 2; ++k) dst[m][k] = *(const PG8_LAS bf16x8*)(lds + PG8_SA(b, h) + aoff + m * 2048 + k * 1024); } while (0)
#define PG8_LDB(dst, b, h) do { _Pragma("unroll") for (int n = 0; n < 2; ++n) _Pragma("unroll") for (int k = 0; k < 2; ++k) dst[n][k] = *(const PG8_LAS bf16x8*)(lds + PG8_SB(b, h) + boff + n * 2048 + k * 1024); } while (0)
#define PG8_MMA(ai, bj, At, Bt) do { __builtin_amdgcn_s_setprio(1); _Pragma("unroll") for (int m = 0; m < 4; ++m) _Pragma("unroll") for (int n = 0; n < 2; ++n) _Pragma("unroll") for (int k = 0; k < 2; ++k) \
        acc[ai][bj][m][n] = __builtin_amdgcn_mfma_f32_16x16x32_bf16(Bt[n][k], At[m][k], acc[ai][bj][m][n], 0, 0, 0); __builtin_amdgcn_s_setprio(0); } while (0)
#define PG8_WAIT_V(n) asm volatile("s_waitcnt vmcnt(" #n ")" ::: "memory")
#define PG8_WAIT_L(n) asm volatile("s_waitcnt lgkmcnt(" #n ")" ::: "memory")
#define PG8_BAR __builtin_amdgcn_s_barrier()
#define PG8_SCHED __builtin_amdgcn_sched_barrier(0)
    Unit cur, nxt; int ui = 0;
    if (!S.next(0, cur)) return;
    f32x4 acc[2][2][4][2];
#pragma unroll
    for (int a = 0; a < 2; ++a)
#pragma unroll
        for (int b = 0; b < 2; ++b)
#pragma unroll
            for (int m = 0; m < 4; ++m)
#pragma unroll
                for (int n = 0; n < 2; ++n) acc[a][b][m][n] = (f32x4){0.f, 0.f, 0.f, 0.f};
    bf16x8 At[4][2], B0[2][2], B1[2][2];
    const char* cA = PG8_ABASE(cur); const char* cB = PG8_BBASE(cur);
    S.a_ready(cur);
    if constexpr (SP2) {
        PG8_STAGE(PG8_SB(0, 0), cB, voffB); PG8_STAGE(PG8_SB(0, 1), cB + hstepB, voffB); PG8_STAGE(PG8_SA(0, 0), cA, voffA); PG8_STAGE(PG8_SA(0, 1), cA + hstepA, voffA);
        PG8_STAGE(PG8_SB(1, 0), cB + kstep, voffB); PG8_STAGE(PG8_SA(1, 0), cA + kstep, voffA); PG8_STAGE(PG8_SB(1, 1), cB + hstepB + kstep, voffB);
        if (wr == 1) PG8_BAR;
        PG8_WAIT_V(8); PG8_BAR;
        PG8_WAIT_V(6); PG8_BAR;
    } else {
        PG8_STAGE(PG8_SB(0, 0), cB, voffB); PG8_STAGE(PG8_SA(0, 0), cA, voffA); PG8_STAGE(PG8_SB(0, 1), cB + hstepB, voffB); PG8_STAGE(PG8_SA(0, 1), cA + hstepA, voffA);
        if (wr == 1) PG8_BAR;
        PG8_WAIT_V(4); PG8_BAR;
        PG8_STAGE(PG8_SB(1, 0), cB + kstep, voffB); PG8_STAGE(PG8_SA(1, 0), cA + kstep, voffA); PG8_STAGE(PG8_SB(1, 1), cB + hstepB + kstep, voffB);
        PG8_WAIT_V(6); PG8_BAR;
    }
    for (;;) {
        const bool has_next = S.next(ui + 1, nxt);
        const char* nA = has_next ? PG8_ABASE(nxt) : cA; const char* nB = has_next ? PG8_BBASE(nxt) : cB;
        for (int t = 0; t < nt; t += 2) {
            const bool last = (t == nt - 2);
            const char* a1 = cA + (size_t)(t + 1) * kstep;
            const char* a2 = last ? nA : cA + (size_t)(t + 2) * kstep; const char* b2 = last ? nB : cB + (size_t)(t + 2) * kstep;
            const char* a3 = a2 + kstep; const char* b3 = b2 + kstep;
            if (last && has_next) S.a_ready(nxt);
            if constexpr (SP2) {
            const bool rz = RL && last && !has_next;
            PG8_LDB(B0, 0, 0); PG8_LDB(B1, 0, 1); PG8_SCHED; PG8_LDA(At, 0, 0); PG8_STAGE(PG8_SA(1, 1), a1 + hstepA, voffA); if (rz) { PG8_STAGE_R(3); }
            PG8_WAIT_V(8); PG8_WAIT_L(0); PG8_BAR; PG8_MMA(0, 0, At, B0); PG8_MMA(0, 1, At, B1); PG8_BAR; PG8_SCHED;
            PG8_LDA(At, 0, 1); if (rz) { PG8_STAGE_R(4); PG8_STAGE_R(5); PG8_STAGE_R(0); } else { PG8_STAGE(PG8_SB(0, 0), b2, voffB); PG8_STAGE(PG8_SB(0, 1), b2 + hstepB, voffB); PG8_STAGE(PG8_SA(0, 0), a2, voffA); }
            PG8_WAIT_V(8); PG8_WAIT_L(0); PG8_BAR; PG8_MMA(1, 0, At, B0); PG8_MMA(1, 1, At, B1); PG8_BAR; PG8_SCHED;
            PG8_LDB(B0, 1, 0); PG8_LDB(B1, 1, 1); PG8_SCHED; PG8_LDA(At, 1, 0); if (rz) { PG8_STAGE_R(1); } else { PG8_STAGE(PG8_SA(0, 1), a2 + hstepA, voffA); }
            PG8_WAIT_V(8); PG8_WAIT_L(0); PG8_BAR; PG8_MMA(0, 0, At, B0); PG8_MMA(0, 1, At, B1); PG8_BAR; PG8_SCHED;
            PG8_LDA(At, 1, 1); if (rz) { PG8_STAGE_R(6); PG8_STAGE_R(7); PG8_STAGE_R(2); } else { PG8_STAGE(PG8_SB(1, 0), b3, voffB); PG8_STAGE(PG8_SB(1, 1), b3 + hstepB, voffB); PG8_STAGE(PG8_SA(1, 0), a3, voffA); }
            PG8_WAIT_V(8); PG8_WAIT_L(0); PG8_BAR; PG8_MMA(1, 0, At, B0); PG8_MMA(1, 1, At, B1); PG8_BAR; PG8_SCHED;
            } else {
            PG8_LDB(B0, 0, 0); PG8_SCHED; PG8_LDA(At, 0, 0); PG8_STAGE(PG8_SA(1, 1), a1 + hstepA, voffA);
            PG8_WAIT_L(8); PG8_BAR; PG8_WAIT_L(0); PG8_MMA(0, 0, At, B0); PG8_BAR; PG8_SCHED;
            PG8_LDB(B1, 0, 1); PG8_STAGE(PG8_SB(0, 0), b2, voffB);
            PG8_BAR; PG8_WAIT_L(0); PG8_MMA(0, 1, At, B1); PG8_BAR;
            PG8_LDA(At, 0, 1); PG8_STAGE(PG8_SA(0, 0), a2, voffA);
            PG8_BAR; PG8_WAIT_L(0); PG8_MMA(1, 0, At, B0); PG8_BAR; PG8_SCHED;
            PG8_STAGE(PG8_SB(0, 1), b2 + hstepB, voffB);
            PG8_WAIT_V(6); PG8_BAR; PG8_MMA(1, 1, At, B1); PG8_BAR;
            PG8_LDB(B0, 1, 0); PG8_SCHED; PG8_LDA(At, 1, 0); PG8_STAGE(PG8_SA(0, 1), a2 + hstepA, voffA);
            PG8_WAIT_L(8); PG8_BAR; PG8_WAIT_L(0); PG8_MMA(0, 0, At, B0); PG8_BAR; PG8_SCHED;
            PG8_LDB(B1, 1, 1); PG8_STAGE(PG8_SB(1, 0), b3, voffB);
            PG8_BAR; PG8_WAIT_L(0); PG8_MMA(0, 1, At, B1); PG8_BAR;
            PG8_LDA(At, 1, 1); PG8_STAGE(PG8_SA(1, 0), a3, voffA);
            PG8_BAR; PG8_WAIT_L(0); PG8_MMA(1, 0, At, B0); PG8_BAR; PG8_SCHED;
            PG8_STAGE(PG8_SB(1, 1), b3 + hstepB, voffB);
            PG8_WAIT_V(6); PG8_BAR; PG8_MMA(1, 1, At, B1); PG8_BAR;
            }
        }
        if constexpr (ALIGN_EPI) { if (wr == 0) PG8_BAR; }
        if constexpr (!Epi::AFTER_DRAIN) { E(acc, cur, wr, wc, fr, fq); S.done(cur); }
        if (!has_next) break;
#pragma unroll
        for (int a = 0; a < 2; ++a)
#pragma unroll
            for (int b = 0; b < 2; ++b)
#pragma unroll
                for (int m = 0; m < 4; ++m)
#pragma unroll
                    for (int n = 0; n < 2; ++n) acc[a][b][m][n] = (f32x4){0.f, 0.f, 0.f, 0.f};
        cur = nxt; cA = nA; cB = nB; ++ui;
        if constexpr (ALIGN_EPI) { if (wr == 1) PG8_BAR; }
    }
    PG8_WAIT_V(0);
    if constexpr (!ALIGN_EPI) { if (wr == 0) PG8_BAR; }
    PG8_BAR;
    if constexpr (Epi::AFTER_DRAIN) { E.fused(acc, cur, wr, wc, fr, fq, lds, wid, lane); S.done(cur); }
#undef PG8_ABASE
#undef PG8_BBASE
#undef PG8_SA
#undef PG8_SB
#undef PG8_STAGE
#undef PG8_LDA
#undef PG8_STAGE_R
#undef PG8_LDB
#undef PG8_MMA
#undef PG8_WAIT_V
#undef PG8_WAIT_L
#undef PG8_BAR
#undef PG8_SCHED
}
}
#include <hip/hip_bf16.h>
#include <cmath>
namespace attn_body {
using bf16=__hip_bfloat16;
using bf16x8=__attribute__((ext_vector_type(8)))short;
using s16x4=__attribute__((ext_vector_type(4)))short;
using f32x16=__attribute__((ext_vector_type(16)))float;
using u32x4=__attribute__((ext_vector_type(4)))unsigned;
constexpr int BATCH=2,NHEAD=8,SEQ=8192,D=64,DV=128,QKP=512,OP=1024;
constexpr int NW=8,QBLK=32,QB=QBLK*NW,KVBLK=64,NQB=SEQ/QB;
constexpr int ATTN_UNIT_ROWS=QB;
__device__ __forceinline__ int crow(int r,int hi){return (r&3)+8*(r>>2)+4*hi;}
#define SBAR() __builtin_amdgcn_sched_barrier(0)
__device__ __forceinline__ void cmask(f32x16&p0,f32x16&p1,int jb,int qrel,int hi){
  const float NEG=-INFINITY; int kb=64*jb+4*hi;
  #pragma unroll
  for(int r=0;r<16;++r){int kv=kb+(r&3)+8*(r>>2); if(kv>qrel)p0[r]=NEG; if(kv+32>qrel)p1[r]=NEG;}
}

constexpr int NSLOT=3, SLOTB=8192;
constexpr int SLOTV=2*SLOTB;
constexpr int NKS=4;
constexpr int LDS_K=0, LDS_V=NKS*SLOTB, LDS_WS=LDS_V+NSLOT*SLOTV, LDS_OST=LDS_WS+NW*64*4, LDS_BYTES=LDS_OST+NW*4096;
constexpr float C2=0.125f*1.4426950408889634f;
__device__ __forceinline__ void glds16(const void*gsrc,unsigned lds_dst){unsigned keep;
  asm volatile("s_mov_b32 %0, m0\n\ts_mov_b32 m0, %2\n\ts_nop 0\n\tglobal_load_lds_dwordx4 %1, off\n\ts_mov_b32 m0, %0":"=&s"(keep):"v"(gsrc),"s"(lds_dst):"memory");}
__device__ __forceinline__ float max3f(float a,float b,float c){float r;asm("v_max3_f32 %0, %1, %2, %3":"=v"(r):"v"(a),"v"(b),"v"(c));return r;}
__device__ __forceinline__ float max2f(float a,float b){float r;asm("v_max_f32_e32 %0, %1, %2":"=v"(r):"v"(a),"v"(b));return r;}
__device__ __forceinline__ float fadd_s(float a,float b){float r;asm("v_add_f32_e32 %0, %1, %2":"=v"(r):"v"(a),"v"(b));return r;}
__device__ __forceinline__ float fsub_s(float a,float b){float r;asm("v_sub_f32_e32 %0, %1, %2":"=v"(r):"v"(a),"v"(b));return r;}
typedef float f32x2_t __attribute__((ext_vector_type(2))); typedef __bf16 bf16x2_t __attribute__((ext_vector_type(2)));
__device__ __forceinline__ unsigned cvtpk_s(float lo,float hi){f32x2_t v={lo,hi};bf16x2_t b=__builtin_convertvector(v,bf16x2_t);return __builtin_bit_cast(unsigned,b);}
#define WAIT_BAR(N) asm volatile("s_waitcnt vmcnt(" #N ") lgkmcnt(0)\n\ts_barrier":::"memory")

__device__ __forceinline__ void qkt(f32x16&p0,f32x16&p1,const char*Kslot,const bf16x8*qr,int r32,int hi){
  const f32x16 negm=f32x16{};
  const char*kb=Kslot+hi*1024+r32*16;
  #pragma unroll
  for(int d0=0;d0<4;++d0){
    const bf16x8 b0=*reinterpret_cast<const bf16x8*>(kb+d0*2048);
    const bf16x8 b1=*reinterpret_cast<const bf16x8*>(kb+d0*2048+512);
    if(d0==0){p0=__builtin_amdgcn_mfma_f32_32x32x16_bf16(b0,qr[0],negm,0,0,0);p1=__builtin_amdgcn_mfma_f32_32x32x16_bf16(b1,qr[0],negm,0,0,0);}
    else{p0=__builtin_amdgcn_mfma_f32_32x32x16_bf16(b0,qr[d0],p0,0,0,0);p1=__builtin_amdgcn_mfma_f32_32x32x16_bf16(b1,qr[d0],p1,0,0,0);}}
}
typedef __attribute__((address_space(3))) const char* lds_cptr;
typedef short v4i16_t __attribute__((ext_vector_type(4)));
__device__ __forceinline__ void kload8(bf16x8*kf,lds_cptr kp){
  kf[0]=*(const __attribute__((address_space(3))) bf16x8*)(kp);      kf[1]=*(const __attribute__((address_space(3))) bf16x8*)(kp+512);
  kf[2]=*(const __attribute__((address_space(3))) bf16x8*)(kp+2048); kf[3]=*(const __attribute__((address_space(3))) bf16x8*)(kp+2560);
  kf[4]=*(const __attribute__((address_space(3))) bf16x8*)(kp+4096); kf[5]=*(const __attribute__((address_space(3))) bf16x8*)(kp+4608);
  kf[6]=*(const __attribute__((address_space(3))) bf16x8*)(kp+6144); kf[7]=*(const __attribute__((address_space(3))) bf16x8*)(kp+6656);
}
__device__ __forceinline__ bf16x8 kload1(lds_cptr kp,int i){ return *(const __attribute__((address_space(3))) bf16x8*)(kp+(i>>1)*2048+(i&1)*512); }
__device__ __forceinline__ void kload2(bf16x8*kf,lds_cptr kp,int j){ kf[2*j]=*(const __attribute__((address_space(3))) bf16x8*)(kp+j*2048); kf[2*j+1]=*(const __attribute__((address_space(3))) bf16x8*)(kp+j*2048+512); }
__device__ __forceinline__ s16x4 vtr(lds_cptr p){ return __builtin_bit_cast(s16x4,__builtin_amdgcn_ds_read_tr16_b64_v4i16((__attribute__((address_space(3))) v4i16_t*)p)); }
__device__ __forceinline__ float rowmax(const f32x16&p0,const f32x16&p1){
  float a=max3f(p0[0],p0[1],p1[0]),b=max3f(p0[2],p0[3],p1[1]);a=max3f(a,p1[2],p1[3]);
  #pragma unroll
  for(int r=4;r<16;r+=4){a=max3f(a,p0[r],p0[r+1]);b=max3f(b,p0[r+2],p0[r+3]);a=max3f(a,p1[r],p1[r+1]);b=max3f(b,p1[r+2],p1[r+3]);}
  const float m=max2f(a,b);
  auto rr=__builtin_amdgcn_permlane32_swap(__float_as_uint(m),__float_as_uint(m),false,false);
  return max2f(__uint_as_float(rr[0]),__uint_as_float(rr[1]));
}
__device__ __forceinline__ void pv(f32x16*o,int vb,bf16x8 pa0,bf16x8 pa1,bf16x8 pa2,bf16x8 pa3){
  #pragma unroll
  for(int d0=0;d0<4;++d0){s16x4 lo[4],hi[4];
    #pragma unroll
    for(int ks=0;ks<4;++ks){
      asm volatile("ds_read_b64_tr_b16 %0,%1 offset:%c2":"=&v"(lo[ks]):"v"(vb),"i"(d0*4096+ks*1024):"memory");
      asm volatile("ds_read_b64_tr_b16 %0,%1 offset:%c2":"=&v"(hi[ks]):"v"(vb),"i"(d0*4096+ks*1024+512):"memory");}
    asm volatile("s_waitcnt lgkmcnt(0)":::"memory");SBAR();
    #define PK(k) (bf16x8){lo[k][0],lo[k][1],lo[k][2],lo[k][3],hi[k][0],hi[k][1],hi[k][2],hi[k][3]}
    o[d0]=__builtin_amdgcn_mfma_f32_32x32x16_bf16(pa0,PK(0),o[d0],0,0,0);
    o[d0]=__builtin_amdgcn_mfma_f32_32x32x16_bf16(pa1,PK(1),o[d0],0,0,0);
    o[d0]=__builtin_amdgcn_mfma_f32_32x32x16_bf16(pa2,PK(2),o[d0],0,0,0);
    o[d0]=__builtin_amdgcn_mfma_f32_32x32x16_bf16(pa3,PK(3),o[d0],0,0,0);
    #undef PK
  }
}

#ifndef ATTN_STORE16
#define ATTN_STORE16(p,v) (*(u32x4*)(p)=(v))
#endif
template<int THRL> __device__ __forceinline__ void attn_unit(int b,int hm,int qb,const bf16*Q,const bf16*__restrict__ K,const bf16*__restrict__ V,bf16*O,char*shm){
  const int qkcol=(hm>>1)*128+(hm&1)*64, vcol=(hm>>1)*128, ocol=(hm&1)*512+(hm>>1)*128;
  int tid_=threadIdx.x; asm volatile("":"+v"(tid_)); int wid_=__builtin_amdgcn_readfirstlane(tid_>>6); asm volatile("":"+s"(wid_));
  const int tid=tid_,lane=tid&63,r32=lane&31,hi=lane>>5; const int wid=wid_;
  const long rowbase=(long)b*SEQ; const int q0=qb*QB;
  const bf16*Qw=Q+(rowbase+q0+wid*QBLK)*QKP+qkcol;
  const bf16*Kh=K+rowbase*QKP+qkcol,*Vh=V+rowbase*QKP+vcol;
  const unsigned lds0=(unsigned)(uintptr_t)shm;
  float*wsf=(float*)(shm+LDS_WS)+wid*64;
  const bf16*ksrc=Kh+(long)lane*QKP+wid*8;
  const bf16*vsrc=Vh+(long)(16*(wid&3)+(lane>>2))*QKP+(wid>>2)*32+(lane&3)*8;
  const unsigned kdst=lds0+LDS_K+wid*1024, vdst=lds0+LDS_V+wid*1024;
  #define KSL(t) ((((t))&3)*SLOTB)
  #define DMA_K(t,slot) glds16(ksrc+(long)(t)*KVBLK*QKP,(unsigned)__builtin_amdgcn_readfirstlane(kdst+(slot)))
  #define DMA_V(t,slot) do{ glds16(vsrc+(long)(t)*KVBLK*QKP,(unsigned)__builtin_amdgcn_readfirstlane(vdst+2*(slot))); glds16(vsrc+64+(long)(t)*KVBLK*QKP,(unsigned)__builtin_amdgcn_readfirstlane(vdst+2*(slot)+8192)); }while(0)
  const int vb0=(int)(lds0+LDS_V)+((lane>>4)&1)*32+(lane&3)*8+(4*hi+((lane&15)>>2))*64;
  const char*Kbase=shm+LDS_K; bf16x8 kf[8];
  const lds_cptr shm3=(lds_cptr)shm; const lds_cptr kp0=shm3+LDS_K+hi*1024+r32*16; const lds_cptr vp0=shm3+LDS_V+((lane>>4)&1)*32+(lane&3)*8+(4*hi+((lane&15)>>2))*64;
  const int NT=(q0+QB)/KVBLK;
  DMA_K(0,0);DMA_V(0,0);DMA_K(1,SLOTB);
  bf16x8 qr[4];
  #pragma unroll
  for(int d0=0;d0<4;++d0)qr[d0]=*reinterpret_cast<const bf16x8*>(&Qw[(long)r32*QKP+d0*16+hi*8]);
  float mhat=0.f,l_reg=0.f;f32x16 o[4];o[0]=f32x16{};o[1]=f32x16{};o[2]=f32x16{};o[3]=f32x16{};f32x16 negm=f32x16{};asm volatile("":"+v"(negm));
  const int qrel=wid*QBLK+r32;
  #define CMASK(P0,P1,t) do{int jb_=(t)-(NT-4); if(jb_>=0)cmask(P0,P1,jb_,qrel,hi);}while(0)
  bool resc=false;
  #define START(P0,P1) do{ const float rm=rowmax(P0,P1); resc=false; \
    { const float dl=rm; mhat=fadd_s(mhat,dl); \
      _Pragma("unroll") for(int r=0;r<16;++r){P0[r]=fsub_s(P0[r],dl);P1[r]=fsub_s(P1[r],dl);} \
      _Pragma("unroll") for(int r=0;r<16;++r)negm[r]=-mhat; asm volatile("":"+v"(negm)); } \
    _Pragma("unroll") for(int r=0;r<16;++r)P0[r]=__builtin_amdgcn_exp2f(P0[r]); }while(0)
  #define RESC() do{ if(resc){ asm volatile("s_waitcnt lgkmcnt(0)":::"memory"); \
      _Pragma("unroll") for(int d_=0;d_<4;++d_) _Pragma("unroll") for(int r=0;r<16;++r)o[d_][r]*=wsf[crow(r,hi)]; } }while(0)
  f32x16 pA0,pA1,pB0,pB1;
  int sl_prev=0,sl_cur=0,sl_next=SLOTB;
  #define ROT() do{sl_prev=sl_cur;sl_cur=sl_next;sl_next=(sl_next==(NSLOT-1)*SLOTB)?0:sl_next+SLOTB;}while(0)
  DMA_K(2,2*SLOTB);
  WAIT_BAR(4);
  qkt(pA0,pA1,Kbase,qr,r32,hi);asm volatile("s_nop 15\n\ts_nop 7":"+v"(pA0),"+v"(pA1));CMASK(pA0,pA1,0);
  START(pA0,pA1);
  _Pragma("unroll") for(int r=0;r<16;++r)pA1[r]=__builtin_amdgcn_exp2f(pA1[r]);
  WAIT_BAR(0);
  DMA_K(3,3*SLOTB);DMA_V(1,SLOTB);
  ROT();
  kload2(kf,kp0+KSL(1),0);
  WAIT_BAR(3);
  s16x4 vlo[8],vhi[8]; u32x4 pw0,pw1,pw2,pw3;
  #define PKW(P,B) cvtpk_s(P[B],P[B+1])
  #define PAF(k) __builtin_bit_cast(bf16x8,pw##k)
  #define VFR(i) (bf16x8){vlo[i][0],vlo[i][1],vlo[i][2],vlo[i][3],vhi[i][0],vhi[i][1],vhi[i][2],vhi[i][3]}
  #define PIN(x) asm volatile("":"+v"(x))
  #define MX3(a,b,c) __builtin_fmaxf(__builtin_fmaxf((a),(b)),(c))
  #define GAPA(MF,A0,A1,A2,A3,W0,W1,PW) do{ MF; sacc+=A0; sacc+=A1; sacc+=A2; sacc+=A3; PIN(sacc); W0; W1; PIN(PW); SBAR(); }while(0)
  #define EX(v) __builtin_amdgcn_exp2f(v)
  #define GAPB(MF,X,B) do{ MF; X[B]=EX(X[B]); X[B+1]=EX(X[B+1]); PIN(X); SBAR(); }while(0)
  #define VRD2(i) do{ vlo[i]=vtr(vp_+((2+((i)>>2))*4096+((i)&3)*1024)); vhi[i]=vtr(vp_+((2+((i)>>2))*4096+((i)&3)*1024+512)); }while(0)
  #define VRD(i) do{ vlo[i]=vtr(vp_+(((i)>>2)*4096+((i)&3)*1024)); vhi[i]=vtr(vp_+(((i)>>2)*4096+((i)&3)*1024+512)); }while(0)
  #define KRD(G,j) do{ if(G){ kload2(kf,kp0+sl_next,j); SBAR(); } }while(0)
  #define STEP(C0,C1,P0,P1,t,GK,GV,GL) do{ SBAR(); \
    const lds_cptr vp_=vp0+2*sl_prev; const lds_cptr kq_=kp0+KSL(t); \
    VRD(0); kf[2]=kload1(kq_,2); SBAR(); float sacc=(P0[0]+P0[1]); \
    GAPA(C0=__builtin_amdgcn_mfma_f32_32x32x16_bf16(kf[0],qr[0],negm,0,0,0), P0[2],P0[3],P0[4],P0[5],     pw0[0]=PKW(P0,0), pw0[1]=PKW(P0,2), pw0); \
    VRD(4); kf[3]=kload1(kq_,3); SBAR(); GAPA(C1=__builtin_amdgcn_mfma_f32_32x32x16_bf16(kf[1],qr[0],negm,0,0,0), P0[6],P0[7],P0[8],P0[9],     pw0[2]=PKW(P0,4), pw0[3]=PKW(P0,6), pw0); \
    VRD(1); kf[4]=kload1(kq_,4); SBAR(); GAPA(C0=__builtin_amdgcn_mfma_f32_32x32x16_bf16(kf[2],qr[1],C0,0,0,0),   P0[10],P0[11],P0[12],P0[13], pw1[0]=PKW(P0,8), pw1[1]=PKW(P0,10), pw1); \
    VRD(5); kf[5]=kload1(kq_,5); SBAR(); GAPA(C1=__builtin_amdgcn_mfma_f32_32x32x16_bf16(kf[3],qr[1],C1,0,0,0),   P0[14],P0[15],P1[0],P1[1],   pw1[2]=PKW(P0,12),pw1[3]=PKW(P0,14), pw1); \
    VRD(2); kf[6]=kload1(kq_,6); SBAR(); GAPA(C0=__builtin_amdgcn_mfma_f32_32x32x16_bf16(kf[4],qr[2],C0,0,0,0),   P1[2],P1[3],P1[4],P1[5],     pw2[0]=PKW(P1,0), pw2[1]=PKW(P1,2), pw2); \
    VRD(6); kf[7]=kload1(kq_,7); SBAR(); GAPA(C1=__builtin_amdgcn_mfma_f32_32x32x16_bf16(kf[5],qr[2],C1,0,0,0),   P1[6],P1[7],P1[8],P1[9],     pw2[2]=PKW(P1,4), pw2[3]=PKW(P1,6), pw2); \
    VRD(3); SBAR(); GAPA(C0=__builtin_amdgcn_mfma_f32_32x32x16_bf16(kf[6],qr[3],C0,0,0,0),   P1[10],P1[11],P1[12],P1[13], pw3[0]=PKW(P1,8), pw3[1]=PKW(P1,10), pw3); \
    VRD(7); SBAR(); GAPA(C1=__builtin_amdgcn_mfma_f32_32x32x16_bf16(kf[7],qr[3],C1,0,0,0),   P1[14],P1[15],0.f,0.f,       pw3[2]=PKW(P1,12),pw3[3]=PKW(P1,14), pw3); \
    l_reg+=sacc; \
    if(GK){DMA_K((t)+3,KSL((t)+3));} if(GV){DMA_V((t)+1,sl_next);} \
    CMASK(C0,C1,t); \
    { float a=MX3(C0[0],C0[1],C1[0]),b=MX3(C0[2],C0[3],C1[1]); a=MX3(a,C1[2],C1[3]); \
      _Pragma("unroll") for(int r=4;r<16;r+=4){a=MX3(a,C0[r],C0[r+1]);b=MX3(b,C0[r+2],C0[r+3]);a=MX3(a,C1[r],C1[r+1]);b=MX3(b,C1[r+2],C1[r+3]);} \
      float rm=__builtin_fmaxf(a,b); { auto rr=__builtin_amdgcn_permlane32_swap(__float_as_uint(rm),__float_as_uint(rm),false,false); rm=__builtin_fmaxf(__uint_as_float(rr[0]),__uint_as_float(rr[1])); } \
      resc=false; \
      if(__builtin_expect(__any(rm>(float)THRL),0)){ const float dl=__builtin_fmaxf(rm,0.f); mhat+=dl; \
        _Pragma("unroll") for(int r=0;r<16;++r){C0[r]-=dl;C1[r]-=dl;} \
        _Pragma("unroll") for(int r=0;r<16;++r)negm[r]=-mhat; asm volatile("":"+v"(negm)); \
        const float f=__builtin_amdgcn_exp2f(-dl); l_reg*=f; if(hi==0)wsf[r32]=f; resc=true; } } \
    SBAR(); \
    GAPB(o[0]=__builtin_amdgcn_mfma_f32_32x32x16_bf16(PAF(0),VFR(0),o[0],0,0,0), C0,0);  VRD2(0); SBAR(); \
    GAPB(o[1]=__builtin_amdgcn_mfma_f32_32x32x16_bf16(PAF(0),VFR(4),o[1],0,0,0), C0,2);  VRD2(4); SBAR(); \
    GAPB(o[0]=__builtin_amdgcn_mfma_f32_32x32x16_bf16(PAF(1),VFR(1),o[0],0,0,0), C0,4);  VRD2(1); SBAR(); \
    GAPB(o[1]=__builtin_amdgcn_mfma_f32_32x32x16_bf16(PAF(1),VFR(5),o[1],0,0,0), C0,6);  VRD2(5); SBAR(); \
    GAPB(o[0]=__builtin_amdgcn_mfma_f32_32x32x16_bf16(PAF(2),VFR(2),o[0],0,0,0), C0,8);  VRD2(2); SBAR(); \
    GAPB(o[1]=__builtin_amdgcn_mfma_f32_32x32x16_bf16(PAF(2),VFR(6),o[1],0,0,0), C0,10); VRD2(6); SBAR(); \
    GAPB(o[0]=__builtin_amdgcn_mfma_f32_32x32x16_bf16(PAF(3),VFR(3),o[0],0,0,0), C0,12); VRD2(3); SBAR(); \
    GAPB(o[1]=__builtin_amdgcn_mfma_f32_32x32x16_bf16(PAF(3),VFR(7),o[1],0,0,0), C0,14); VRD2(7); SBAR(); \
    GAPB(o[2]=__builtin_amdgcn_mfma_f32_32x32x16_bf16(PAF(0),VFR(0),o[2],0,0,0), C1,0); \
    GAPB(o[3]=__builtin_amdgcn_mfma_f32_32x32x16_bf16(PAF(0),VFR(4),o[3],0,0,0), C1,2); \
    GAPB(o[2]=__builtin_amdgcn_mfma_f32_32x32x16_bf16(PAF(1),VFR(1),o[2],0,0,0), C1,4); \
    GAPB(o[3]=__builtin_amdgcn_mfma_f32_32x32x16_bf16(PAF(1),VFR(5),o[3],0,0,0), C1,6); \
    GAPB(o[2]=__builtin_amdgcn_mfma_f32_32x32x16_bf16(PAF(2),VFR(2),o[2],0,0,0), C1,8); \
    GAPB(o[3]=__builtin_amdgcn_mfma_f32_32x32x16_bf16(PAF(2),VFR(6),o[3],0,0,0), C1,10); \
    GAPB(o[2]=__builtin_amdgcn_mfma_f32_32x32x16_bf16(PAF(3),VFR(3),o[2],0,0,0), C1,12); \
    GAPB(o[3]=__builtin_amdgcn_mfma_f32_32x32x16_bf16(PAF(3),VFR(7),o[3],0,0,0), C1,14); \
    if(GL){ kload2(kf,kp0+KSL((t)+1),0); SBAR(); } \
    }while(0)
  int t=1;
  #undef CMASK
  #define CMASK(P0,P1,t) do{}while(0)
  for(;t+5<NT;t+=2){
    STEP(pB0,pB1,pA0,pA1,t,true,true,true);     WAIT_BAR(3); RESC(); ROT();
    STEP(pA0,pA1,pB0,pB1,t+1,true,true,true);   WAIT_BAR(3); RESC(); ROT();
  }
  #undef CMASK
  #define CMASK(P0,P1,t) do{int jb_=(t)-(NT-4); if(jb_>=0)cmask(P0,P1,jb_,qrel,hi);}while(0)
  #define ENDW(tt) do{ if((tt)+3<NT){WAIT_BAR(3);} else if((tt)+2<NT){WAIT_BAR(2);} else {WAIT_BAR(0);} }while(0)
  for(;t+1<NT;t+=2){
    STEP(pB0,pB1,pA0,pA1,t,(t+3<NT),(t+1<NT),(t+1<NT));       ENDW(t);   RESC(); ROT();
    STEP(pA0,pA1,pB0,pB1,t+1,(t+4<NT),(t+2<NT),(t+2<NT));     ENDW(t+1); RESC(); ROT();
  }
  STEP(pB0,pB1,pA0,pA1,NT-1,false,false,false); RESC();
  { float sacc=pB0[0]+pB0[1]; _Pragma("unroll") for(int r=2;r<16;++r)sacc+=pB0[r]; _Pragma("unroll") for(int r=0;r<16;++r)sacc+=pB1[r]; l_reg+=sacc;
    pw0=(u32x4){PKW(pB0,0),PKW(pB0,2),PKW(pB0,4),PKW(pB0,6)};pw1=(u32x4){PKW(pB0,8),PKW(pB0,10),PKW(pB0,12),PKW(pB0,14)};pw2=(u32x4){PKW(pB1,0),PKW(pB1,2),PKW(pB1,4),PKW(pB1,6)};pw3=(u32x4){PKW(pB1,8),PKW(pB1,10),PKW(pB1,12),PKW(pB1,14)};
    SBAR(); pv(o,vb0+2*sl_cur,PAF(0),PAF(1),PAF(2),PAF(3)); }
  #undef PKW
  #undef PAF
  #undef VFR
  #undef PIN
  #undef MX3
  #undef GAPA
  #undef GAPB
  #undef EX
  #undef VRD
  #undef VRD2
  #undef KRD
  #undef STEP
  #undef ENDW
  {auto rr=__builtin_amdgcn_permlane32_swap(__float_as_uint(l_reg),__float_as_uint(l_reg),false,false);l_reg=__uint_as_float(rr[0])+__uint_as_float(rr[1]);}
  if(hi==0)wsf[32+r32]=l_reg;asm volatile("s_waitcnt lgkmcnt(0)":::"memory");
  float rli[16];
  #pragma unroll
  for(int r=0;r<16;++r)rli[r]=__builtin_amdgcn_rcpf(wsf[32+crow(r,hi)]);
  bf16*Ow=O+(rowbase+q0+wid*QBLK)*OP+ocol;
  { bf16*stg=(bf16*)(shm+LDS_OST)+wid*2048;
    #pragma unroll
    for(int p=0;p<2;++p){
      #pragma unroll
      for(int r=0;r<16;++r){const int orow=crow(r,hi);
        #pragma unroll
        for(int d0=0;d0<2;++d0)stg[orow*64+d0*32+r32]=__float2bfloat16(o[2*p+d0][r]*rli[r]);}
      asm volatile("s_waitcnt lgkmcnt(0)":::"memory");
      #pragma unroll
      for(int i=0;i<4;++i){const int row=i*8+(lane>>3),ch=lane&7; const u32x4 v=*(const u32x4*)(stg+row*64+ch*8); ATTN_STORE16(Ow+(long)row*OP+p*64+ch*8,v);}
      asm volatile("s_waitcnt lgkmcnt(0)":::"memory"); } }
  asm volatile("s_waitcnt lgkmcnt(0)\n\ts_barrier":::"memory");
  #undef DMA_K
  #undef DMA_V
  #undef CMASK
  #undef START
  #undef RESC
  #undef ROT
}
constexpr int ATTN_LDS_BYTES=LDS_BYTES;
struct AttnTensors { const bf16* Q; const bf16* K; const bf16* V; bf16* O; };
struct AttnUnit { int bh; int qb; };
struct StaticOrder {
  int vcu;
  __device__ __forceinline__ explicit StaticOrder(int grid,int block):vcu((block%8)*(grid/8)+block/8){}
  __device__ __forceinline__ bool next(int i,AttnUnit&u)const{ if(i>=2)return false; const int s=vcu&15; u.bh=vcu>>4; u.qb=(i==0)?s:31-s; return true; }
  __device__ __forceinline__ void a_ready(const AttnUnit&)const{}
  __device__ __forceinline__ void done(const AttnUnit&)const{}
};
template<class Sched,int THRL=8> __device__ __forceinline__ void attn_phase(char*lds,const AttnTensors&T,const Sched&S){
  AttnUnit u;
  for(int i=0;S.next(i,u);++i){ S.a_ready(u); attn_unit<THRL>(u.bh/NHEAD,u.bh%NHEAD,u.qb,T.Q,T.K,T.V,T.O,lds); S.done(u); }
}
#undef SBAR
#undef WAIT_BAR
}
#define GAS __attribute__((address_space(1)))
#define LAS __attribute__((address_space(3)))
typedef unsigned short bf16;
typedef unsigned v4u __attribute__((ext_vector_type(4)));
typedef float f32x4 __attribute__((ext_vector_type(4)));
typedef short bf16x8 __attribute__((ext_vector_type(8)));
typedef GAS unsigned gu32;
typedef GAS unsigned long long gu64;
#define RLX_AGENT __ATOMIC_RELAXED, __HIP_MEMORY_SCOPE_AGENT
#define LDS_WAIT() asm volatile("s_waitcnt lgkmcnt(0)" ::: "memory")
#define VM_WAIT() asm volatile("s_waitcnt vmcnt(0)" ::: "memory")
__device__ __forceinline__ unsigned long long rt() { return __builtin_amdgcn_s_memrealtime(); }
__device__ __forceinline__ unsigned f2bf(float f) { unsigned u = __builtin_bit_cast(unsigned, f); return (u + 0x7fffu + ((u >> 16) & 1u)) >> 16; }
__device__ __forceinline__ unsigned pk2(float lo, float hi) { return f2bf(lo) | (f2bf(hi) << 16); }

#define XB_TMO      128
#define XB_XCNT(j)  (256  + 64 * (j))
#define XB_XSUB(j)  (1280 + 64 * (j))
#define XB_XGEN(j)  (2304 + 64 * (j))
#define XB_TOP      3328
#define XB_TOPGEN   3392
#define XCD_BAR_WORDS 3456
#define XB_SPIN_CAP (1u << 18)

__device__ __forceinline__ unsigned xb_ld(unsigned* p)              { return __hip_atomic_load(p, __ATOMIC_RELAXED, __HIP_MEMORY_SCOPE_AGENT); }
__device__ __forceinline__ unsigned xb_add(unsigned* p, unsigned v) { return __hip_atomic_fetch_add(p, v, __ATOMIC_RELAXED, __HIP_MEMORY_SCOPE_AGENT); }
__device__ __forceinline__ unsigned xb_xcc_id() { return (unsigned)__builtin_amdgcn_s_getreg((3 << 11) | 20) & 0xFu; }
#define XB_SPIN(cond, bar) do { unsigned _sp = 0; while (cond) { __builtin_amdgcn_s_sleep(3); \
    if ((++_sp & 255u) == 0u) { if (xb_ld(&(bar)[XB_TMO])) break; if (_sp > XB_SPIN_CAP) { atomicAdd(&(bar)[XB_TMO], 1u); break; } } } } while (0)

struct XcdBarrier {
    unsigned* bar; unsigned x;
    volatile LAS unsigned* st;
};

__device__ __forceinline__ XcdBarrier xcd_barrier_post(unsigned* bar, volatile LAS unsigned* st) {
    XcdBarrier b; b.bar = bar; b.x = xb_xcc_id(); b.st = st;
    if (threadIdx.x == 0) (void)xb_add(&bar[XB_XCNT(b.x)], 1u);
    return b;
}
__device__ __forceinline__ void xcd_barrier_complete(unsigned* bar, unsigned x, unsigned& nloc, unsigned& nx) {
    const unsigned G = gridDim.x * gridDim.y * gridDim.z;
    unsigned sum, cnt, mine, sp = 0u;
    for (;;) {
        sum = 0u; cnt = 0u; mine = 0u;
#pragma unroll
        for (unsigned j = 0; j < 16; ++j) { const unsigned c = xb_ld(&bar[XB_XCNT(j)]); sum += c; cnt += (c > 0u) ? 1u : 0u; mine = (j == x) ? c : mine; }
        if (sum == G) break;
        __builtin_amdgcn_s_sleep(1);
        if ((++sp & 255u) == 0u) { if (xb_ld(&bar[XB_TMO])) break; if (sp > XB_SPIN_CAP) { atomicAdd(&bar[XB_TMO], 1u); break; } }
    }
    nloc = mine > 0u ? mine : 1u; nx = cnt > 0u ? cnt : 1u;
}

__device__ __forceinline__ void xcd_barrier(const XcdBarrier& b) {
    asm volatile("s_waitcnt vmcnt(0)" ::: "memory");
    __syncthreads();
    if (threadIdx.x == 0) {
        unsigned* bar = b.bar; const unsigned bx = (unsigned)__builtin_amdgcn_readfirstlane((int)xb_xcc_id());
        __builtin_amdgcn_s_waitcnt(0);
        unsigned nloc = b.st[0], nx = b.st[1];
        if (nloc == 0u) { xcd_barrier_complete(bar, bx, nloc, nx); b.st[0] = nloc; b.st[1] = nx; }
        const unsigned old = xb_add(&bar[XB_XSUB(bx)], 1u);
        const unsigned gen = old / nloc;
        if (old + 1u == (gen + 1u) * nloc) {
            __builtin_amdgcn_fence(__ATOMIC_RELEASE, "agent");
            asm volatile("s_waitcnt vmcnt(0)" ::: "memory");
            const unsigned og = xb_add(&bar[XB_TOP], 1u);
            const unsigned tg = og / nx;
            if (og + 1u == (tg + 1u) * nx) xb_add(&bar[XB_TOPGEN], 1u);
            else XB_SPIN((int)(xb_ld(&bar[XB_TOPGEN]) - tg) <= 0, bar);
            __builtin_amdgcn_fence(__ATOMIC_ACQUIRE, "agent");
            xb_add(&bar[XB_XGEN(bx)], 1u);
            asm volatile("s_waitcnt vmcnt(0)" ::: "memory");
        } else {
            XB_SPIN((int)(xb_ld(&bar[XB_XGEN(bx)]) - gen) <= 0, bar);
            __builtin_amdgcn_fence(__ATOMIC_ACQUIRE, "agent");
            asm volatile("s_waitcnt vmcnt(0)" ::: "memory");
        }
    }
    __syncthreads();
}

__device__ __forceinline__ void xcd_arrive(const XcdBarrier& b) {
    asm volatile("s_waitcnt vmcnt(0)" ::: "memory");
    __syncthreads();
    if (threadIdx.x == 0) {
        unsigned* bar = b.bar; const unsigned bx = (unsigned)__builtin_amdgcn_readfirstlane((int)xb_xcc_id());
        __builtin_amdgcn_s_waitcnt(0);
        const unsigned nloc = b.st[0], nx = b.st[1];
        const unsigned old = xb_add(&bar[XB_XSUB(bx)], 1u);
        const unsigned gen = old / nloc;
        b.st[3] = gen;
        if (old + 1u == (gen + 1u) * nloc) {
            __builtin_amdgcn_fence(__ATOMIC_RELEASE, "agent");
            asm volatile("s_waitcnt vmcnt(0)" ::: "memory");
            const unsigned og = xb_add(&bar[XB_TOP], 1u);
            const unsigned tg = og / nx;
            if (og + 1u == (tg + 1u) * nx) xb_add(&bar[XB_TOPGEN], 1u);
            xb_add(&bar[XB_XGEN(bx)], 1u);
        }
    }
}
__device__ __forceinline__ void xcd_wait(const XcdBarrier& b) {
    if (threadIdx.x == 0) {
        unsigned* bar = b.bar; const unsigned gen = b.st[3];
        XB_SPIN((int)(xb_ld(&bar[XB_TOPGEN]) - gen) <= 0, bar);
        __builtin_amdgcn_fence(__ATOMIC_ACQUIRE, "agent");
        asm volatile("s_waitcnt vmcnt(0)" ::: "memory");
    }
    __syncthreads();
}

#ifndef REPMASK
#define REPMASK 0
#endif
constexpr int NWAVES = 8;
constexpr int BATCH = 2, SEQ = 8192, DMODEL = 1024, DEPTH = 2, NMEM = 256, DFF = 2816, DIN = 2560;
constexpr int M = BATCH * SEQ;
constexpr float C2_DIFF = 0.125f * 1.4426950408889634f;
constexpr float C2_CROSS = 0.0625f * 1.4426950408889634f;
constexpr size_t MiB = 1u << 20;
constexpr size_t WS_CTL = 0, CTL_ZERO_BYTES = 64 * 1024;
constexpr size_t WS_STATS = 1 * MiB;
constexpr size_t WS_CS = 2 * MiB;
constexpr size_t WS_MEMN = 3 * MiB;
constexpr size_t WS_KC = 4 * MiB;
constexpr size_t WS_VC = 6 * MiB;
constexpr size_t WS_W = 8 * MiB;
constexpr size_t W_GU = (size_t)2 * DFF * DMODEL * 2, W_D = (size_t)DMODEL * DFF * 2, W_IN = (size_t)DIN * DMODEL * 2, W_SQ = (size_t)DMODEL * DMODEL * 2;
constexpr size_t WO_GU1 = 0, WO_D1 = WO_GU1 + W_GU, WO_IN = WO_D1 + W_D, WO_OUT = WO_IN + W_IN, WO_Q = WO_OUT + W_SQ, WO_O = WO_Q + W_SQ, WO_GU2 = WO_O + W_SQ, WO_D2 = WO_GU2 + W_GU, W_LAYER = WO_D2 + W_D;
constexpr size_t WS_WKV = WS_W + W_LAYER;
constexpr size_t WS_HB = 60 * MiB;
constexpr size_t WS_LO = 92 * MiB;
constexpr size_t WS_X1 = WS_LO;
constexpr size_t WS_X2 = WS_LO + 8 * MiB;
constexpr size_t WS_R1 = 124 * MiB;
constexpr size_t R1_HMID = 0;
constexpr size_t R1_Q = 0, R1_T = 16 * MiB;
constexpr size_t R1_O12 = 80 * MiB;
constexpr size_t R1_AG = 0;
constexpr size_t R1_P = 32 * MiB;
constexpr size_t WS_END = 236 * MiB;
static_assert(W_LAYER == 44 * MiB && WS_WKV + (size_t)2 * 2048 * 1024 * 2 == WS_HB && WS_HB + (size_t)M * 1024 * 2 == WS_LO && WS_LO + 32 * MiB == WS_R1 && WS_R1 + 112 * MiB == WS_END, "d_ws map");
constexpr int CW_BAR = 4096;
constexpr int CW_PANEL = 12288;
static_assert((CW_PANEL + 64 * 16) * 4 <= 64 * 1024, "panel counters inside the memset region");
constexpr int RING_OFF = 0, RING_BYTES = 147456;
constexpr int LDSCTL_OFF = RING_BYTES, MISC_OFF = LDSCTL_OFF + 320;
constexpr int LDS_BYTES = 147456 + 1024 + 4096;
static_assert(pg8::RESID_P_OFF == RING_BYTES + 1024 && pg8::RESID_P_OFF + 4096 <= LDS_BYTES, "exchange area");
static_assert(MISC_OFF + 128 <= LDS_BYTES, "LDS map");
static_assert((CW_BAR + 3456) * 4 <= (int)CTL_ZERO_BYTES, "CTL words inside the memset region");

struct Args { const float* in[27]; float* out; unsigned char* ws; };
typedef const __attribute__((address_space(4))) Args* KArgs;
#define AS1(T, p) ((T*)(__attribute__((address_space(1))) T*)(p))
#define INP(a, i) AS1(const float, (a).in[i])
#define OUTP(a) AS1(float, (a).out)
#define WSP(a) AS1(unsigned char, (a).ws)

__device__ __forceinline__ float wave_sum(float v) {
#pragma unroll
    for (int o = 1; o < 64; o <<= 1) v += __shfl_xor(v, o);
    return v;
}
struct TJob { const float* src; const float* gain; bf16* dst; int N, K, k0, n0, d0; bool plain; };
struct TTile { f32x4 v[16]; float g[16]; };
__device__ __forceinline__ void tr_load(const TJob& j, TTile& t, int lane) {
    const int q = lane & 15, r = lane >> 4;
#pragma unroll
    for (int i = 0; i < 8; ++i)
#pragma unroll
        for (int h = 0; h < 2; ++h) { const int k = j.k0 + 8 * i + 2 * r + h;
            t.v[2 * i + h] = __builtin_nontemporal_load((const GAS f32x4*)(j.src + (size_t)k * j.N + j.n0 + 4 * q));     t.g[2 * i + h] = j.gain ? j.gain[k] : 1.0f; }
}
__device__ __forceinline__ void tr_store(const TJob& j, const TTile& t, LAS unsigned* T, int lane) {
    const int q = lane & 15, r = lane >> 4;
    if (j.plain) {
#pragma unroll
        for (int i = 0; i < 8; ++i)
#pragma unroll
            for (int h = 0; h < 2; ++h) { const f32x4 a = t.v[2 * i + h] * t.g[2 * i + h]; const int k = j.k0 + 8 * i + 2 * r + h;
                *(GAS unsigned long long*)(j.dst + (size_t)k * j.N + j.n0 + 4 * q) = (unsigned long long)pg8::cvt_pk_bf16(a[0], a[1]) | ((unsigned long long)pg8::cvt_pk_bf16(a[2], a[3]) << 32); }
        return;
    }
#pragma unroll
    for (int i = 0; i < 8; ++i) { const f32x4 a = t.v[2 * i] * t.g[2 * i], b = t.v[2 * i + 1] * t.g[2 * i + 1]; const int kp = r + 4 * i;
#pragma unroll
        for (int e = 0; e < 4; ++e) T[(4 * q + e) * 33 + kp] = pg8::cvt_pk_bf16(a[e], b[e]); }
    LDS_WAIT(); asm volatile("" ::: "memory");
    const int c = lane & 7;
#pragma unroll
    for (int jj = 0; jj < 8; ++jj) { const int n = (lane >> 3) + 8 * jj; const LAS unsigned* s = T + n * 33 + 4 * c;
        v4u o; o.x = s[0]; o.y = s[1]; o.z = s[2]; o.w = s[3];
        *(GAS v4u*)(j.dst + (size_t)(j.d0 + n) * j.K + j.k0 + 8 * c) = o; }
    LDS_WAIT(); asm volatile("" ::: "memory");
}
__device__ __forceinline__ void sincos_d(float af, float& sn, float& cs) {
    const double a = (double)af; const double kq = __builtin_rint(a * 0.6366197723675814); const double r = __builtin_fma(-kq, 1.5707963267948966, a) - kq * 6.123233995736766e-17;
    const double r2 = r * r;
    const double sp = r * (1.0 + r2 * (-1.0 / 6 + r2 * (1.0 / 120 + r2 * (-1.0 / 5040 + r2 * (1.0 / 362880 + r2 * (-1.0 / 39916800 + r2 * (1.0 / 6227020800.0)))))));
    const double cp = 1.0 + r2 * (-0.5 + r2 * (1.0 / 24 + r2 * (-1.0 / 720 + r2 * (1.0 / 40320 + r2 * (-1.0 / 3628800 + r2 * (1.0 / 479001600 + r2 * (-1.0 / 87178291200.0)))))));
    const int q = ((int)(long long)kq) & 3;
    const double s_ = (q & 1) ? cp : sp, c_ = (q & 1) ? sp : cp;
    sn = (float)((q & 2) ? -s_ : s_); cs = (float)(((q == 1) || (q == 2)) ? -c_ : c_);
}

struct Frame { LAS unsigned char* lds; int tid, lane, wave, vcu, G; };

constexpr int I_GU = 16 * 88, I_D = 44 * 16, I_IN = 16 * 40, I_SQ = 16 * 16, I_KV = 16 * 32, I_LAYER = 2 * I_GU + 2 * I_D + I_IN + 3 * I_SQ + I_KV;
constexpr int IT_GU1 = 0, IT_KV = I_GU, IT_D1 = IT_KV + I_KV, IT_GU2 = IT_D1 + I_D + I_IN + 3 * I_SQ, IT_END = I_LAYER;
static_assert(IT_D1 - IT_GU1 == 2048 - 128, "the prologue's conversion items leave exactly 128 of the 2048 waves free (they normalize the memory tokens)");
__device__ __forceinline__ void convert_items(KArgs ap, const Frame& F, int l, int first, int last, int w, int nw) {
#define a (*ap)
    unsigned char* ws = WSP(a);
    auto decode = [&](int r, TJob& j) {
        unsigned char* wl = ws + WS_W;
        bool sw = false; j.plain = false;
        if (r < I_GU) { j.src = INP(a, 4) + (size_t)l * DMODEL * 2 * DFF; j.K = DMODEL; j.N = 2 * DFF; j.dst = (bf16*)(wl + WO_GU1); j.gain = INP(a, 3) + l * DMODEL; sw = true; }
        else if ((r -= I_GU) < I_KV) { j.src = INP(a, 21) + (size_t)l * DMODEL * 2 * DMODEL; j.K = DMODEL; j.N = 2 * DMODEL; j.dst = (bf16*)(ws + WS_WKV) + (size_t)l * 2048 * 1024; j.gain = INP(a, 19) + l * DMODEL; }
        else if ((r -= I_KV) < I_D) { j.src = INP(a, 5) + (size_t)l * DFF * DMODEL; j.K = DFF; j.N = DMODEL; j.dst = (bf16*)(wl + WO_D1); j.gain = nullptr; }
        else if ((r -= I_D) < I_IN) { j.src = INP(a, 7) + (size_t)l * DMODEL * DIN; j.K = DMODEL; j.N = DIN; j.dst = (bf16*)(wl + WO_IN); j.gain = INP(a, 6) + l * DMODEL; }
        else if ((r -= I_IN) < I_SQ) { j.src = INP(a, 17) + (size_t)l * DMODEL * DMODEL; j.K = DMODEL; j.N = DMODEL; j.dst = (bf16*)(wl + WO_OUT); j.gain = nullptr; }
        else if ((r -= I_SQ) < I_SQ) { j.src = INP(a, 20) + (size_t)l * DMODEL * DMODEL; j.K = DMODEL; j.N = DMODEL; j.dst = (bf16*)(wl + WO_Q); j.gain = INP(a, 18) + l * DMODEL; j.plain = true; }
        else if ((r -= I_SQ) < I_SQ) { j.src = INP(a, 22) + (size_t)l * DMODEL * DMODEL; j.K = DMODEL; j.N = DMODEL; j.dst = (bf16*)(wl + WO_O); j.gain = nullptr; }
        else if ((r -= I_SQ) < I_GU) { j.src = INP(a, 24) + (size_t)l * DMODEL * 2 * DFF; j.K = DMODEL; j.N = 2 * DFF; j.dst = (bf16*)(wl + WO_GU2); j.gain = INP(a, 23) + l * DMODEL; sw = true; }
        else { r -= I_GU; j.src = INP(a, 25) + (size_t)l * DFF * DMODEL; j.K = DFF; j.N = DMODEL; j.dst = (bf16*)(wl + WO_D2); j.gain = nullptr; }
        const int nblk = j.N >> 6, kb = r / nblk, nb = r - kb * nblk; j.k0 = 64 * kb; j.n0 = 64 * nb; j.d0 = j.n0;
        if (sw) { const int half = j.N >> 1, up = (j.n0 >= half) ? 1 : 0, jc = j.n0 - up * half; j.d0 = 256 * (jc >> 7) + 128 * up + (jc & 127); }
    };
    LAS unsigned* T = (LAS unsigned*)(F.lds + RING_OFF + F.wave * 16384); TJob jc, jn; TTile tc, tn; int it = first + w;
    if (it < last) { decode(it, jc); tr_load(jc, tc, F.lane);
        for (;;) { const int nx = it + nw; const bool more = nx < last;
            if (more) { decode(nx, jn); tr_load(jn, tn, F.lane); }
            tr_store(jc, tc, T, F.lane);
            if (!more) break;
            jc = jn; tc = tn; it = nx; } }
#undef a
}
__device__ __forceinline__ void p0_prologue(KArgs ap, const Frame& F) {
#define a (*ap)
    const int gw = F.vcu * NWAVES + F.wave, NGW = F.G * NWAVES;
    unsigned char* ws = WSP(a);
    convert_items(ap, F, 0, IT_GU1, IT_D1, gw, NGW);
    { const float* x = INP(a, 0); bf16* hb = (bf16*)(ws + WS_HB); float* stats = (float*)(ws + WS_STATS);
      for (int m0 = gw; m0 < M; m0 += 4 * NGW) { f32x4 v[4][4];
#pragma unroll
          for (int q = 0; q < 4; ++q) { const int m = m0 + q * NGW; const GAS f32x4* xr = (const GAS f32x4*)(x + (size_t)(m < M ? m : gw) * DMODEL) + F.lane;
#pragma unroll
              for (int j = 0; j < 4; ++j) v[q][j] = __builtin_nontemporal_load(xr + 64 * j); }
#pragma unroll
          for (int q = 0; q < 4; ++q) { const int m = m0 + q * NGW; float s = 0.f;
#pragma unroll
              for (int j = 0; j < 4; ++j) s += (v[q][j].x * v[q][j].x + v[q][j].y * v[q][j].y) + (v[q][j].z * v[q][j].z + v[q][j].w * v[q][j].w);
              s = wave_sum(s);
              if (m < M) { GAS unsigned long long* o8 = (GAS unsigned long long*)(hb + (size_t)m * DMODEL) + F.lane;
#pragma unroll
                  for (int j = 0; j < 4; ++j) o8[64 * j] = (unsigned long long)pg8::cvt_pk_bf16(v[q][j].x, v[q][j].y) | ((unsigned long long)pg8::cvt_pk_bf16(v[q][j].z, v[q][j].w) << 32);
                  if (F.lane == 0) *(GAS f32x4*)(stats + (size_t)m * 4) = (f32x4){s, 0.f, 0.f, 0.f}; } } } }
    { const float* mem = INP(a, 1); bf16* mn = (bf16*)(ws + WS_MEMN);
      for (int m = gw - (NGW - 128); m >= 0 && m < BATCH * NMEM; m += 128) { const GAS f32x4* xr = (const GAS f32x4*)(mem + (size_t)m * DMODEL) + F.lane; f32x4 v[4]; float s = 0.f;
#pragma unroll
          for (int j = 0; j < 4; ++j) { v[j] = xr[64 * j]; s += (v[j].x * v[j].x + v[j].y * v[j].y) + (v[j].z * v[j].z + v[j].w * v[j].w); }
          const float r = 1.0f / sqrtf(wave_sum(s) * (1.0f / DMODEL) + 1e-6f);
          GAS unsigned long long* o8 = (GAS unsigned long long*)(mn + (size_t)m * DMODEL) + F.lane;
#pragma unroll
          for (int j = 0; j < 4; ++j) o8[64 * j] = (unsigned long long)pg8::cvt_pk_bf16(v[j].x * r, v[j].y * r) | ((unsigned long long)pg8::cvt_pk_bf16(v[j].z * r, v[j].w * r) << 32); } }
    { const int* pos = AS1(const int, (const int*)(a).in[2]); float* cs = (float*)(ws + WS_CS);
      const float invf[8] = {1.0f, 0.193922758102417f, 0.03760603070259094f, 0.00729266507551074f, 0.001414213445968926f, 0.00027424818836152554f, 5.318296462064609e-05f, 1.0313385246263351e-05f};
      for (int idx = gw * 64 + F.lane; idx < M * 8; idx += NGW * 64) { const int row = idx >> 3, j = idx & 7;
          float iv = invf[0];
#pragma unroll
          for (int q = 1; q < 8; ++q) iv = (j == q) ? invf[q] : iv;
          const float ang = (float)pos[row] * iv; float sn, c; sincos_d(ang, sn, c); cs[(size_t)row * 16 + j] = c; cs[(size_t)row * 16 + 8 + j] = sn; } }
}

#undef a
template <class Mid>
__device__ __forceinline__ void gmlp_pair(int cp, int g, const bf16* gu, const bf16* gv, const float* Wl, const float* bsl, const float* lng, const float* lnb, bf16* AG, LAS unsigned char* lds, int wave, int lane, const Mid& mid) {
    constexpr int VP = 136;
    const int t0 = 16 * wave, fr = lane & 15, fq = lane >> 4;
    const int tl = 16 * wave + (lane >> 2), c0 = (lane & 3) * 32;
    v4u gw4[2][4]; f32x4 lg[8], lb[8]; f32x4 wq[4][2]; unsigned long long gu8[2][8];
#pragma unroll
    for (int ch = 0; ch < 2; ++ch) { const size_t grow = (size_t)(2 * cp + ch) * 128 + tl; const GAS v4u* src = (const GAS v4u*)(gv + grow * 512 + g * 128 + c0);
#pragma unroll
        for (int q = 0; q < 4; ++q) gw4[ch][q] = src[q]; }
#pragma unroll
    for (int q = 0; q < 8; ++q) { lg[q] = *(const GAS f32x4*)(lng + g * 128 + c0 + 4 * q); lb[q] = *(const GAS f32x4*)(lnb + g * 128 + c0 + 4 * q); }
    { const int t = t0 + fr;
#pragma unroll
      for (int ks = 0; ks < 4; ++ks) { const float* wp = Wl + ((size_t)g * 128 + t) * 128 + 32 * ks + 8 * fq; wq[ks][0] = *(const GAS f32x4*)wp; wq[ks][1] = *(const GAS f32x4*)(wp + 4); }
#pragma unroll
      for (int ch = 0; ch < 2; ++ch)
#pragma unroll
          for (int nb = 0; nb < 8; ++nb) gu8[ch][nb] = *(const GAS unsigned long long*)(gu + ((size_t)(2 * cp + ch) * 128 + t) * 512 + g * 128 + 16 * nb + 4 * fq); }
    const float bt = bsl[g * 128 + t0 + fr];
#pragma unroll
    for (int ch = 0; ch < 2; ++ch) { LAS bf16* vnT = (LAS bf16*)(lds + ch * 36864); float v[32];
#pragma unroll
      for (int q = 0; q < 4; ++q) { const v4u w = gw4[ch][q];
#pragma unroll
          for (int e = 0; e < 4; ++e) { const unsigned ww = w[e]; v[q * 8 + 2 * e] = __uint_as_float(ww << 16); v[q * 8 + 2 * e + 1] = __uint_as_float(ww & 0xffff0000u); } }
      float s = 0.f;
#pragma unroll
      for (int i = 0; i < 32; ++i) s += v[i];
      s += __shfl_xor(s, 1); s += __shfl_xor(s, 2);
      const float mean = s * (1.0f / 128.0f); float q2 = 0.f;
#pragma unroll
      for (int i = 0; i < 32; ++i) { v[i] -= mean; q2 += v[i] * v[i]; }
      q2 += __shfl_xor(q2, 1); q2 += __shfl_xor(q2, 2);
      const float rstd = 1.0f / sqrtf(q2 * (1.0f / 128.0f) + 1e-6f);
#pragma unroll
      for (int i = 0; i < 32; i += 2) { const float y0 = v[i] * rstd * lg[i >> 2][i & 3] + lb[i >> 2][i & 3], y1 = v[i + 1] * rstd * lg[(i + 1) >> 2][(i + 1) & 3] + lb[(i + 1) >> 2][(i + 1) & 3];
          const unsigned w = pg8::cvt_pk_bf16(y0, y1); vnT[(c0 + i) * VP + tl] = (bf16)(w & 0xffffu); vnT[(c0 + i + 1) * VP + tl] = (bf16)(w >> 16); } }
    const int nks = (t0 + 15) / 32 + 1;
    bf16x8 wfrag[4];
#pragma unroll
    for (int ks = 0; ks < 4; ++ks) { const int t = t0 + fr, s0 = 32 * ks + 8 * fq;
        float wv[8] = {wq[ks][0].x, wq[ks][0].y, wq[ks][0].z, wq[ks][0].w, wq[ks][1].x, wq[ks][1].y, wq[ks][1].z, wq[ks][1].w};
#pragma unroll
        for (int j = 0; j < 8; ++j) wv[j] = (s0 + j <= t) ? wv[j] : 0.f;
        v4u wf; wf.x = pg8::cvt_pk_bf16(wv[0], wv[1]); wf.y = pg8::cvt_pk_bf16(wv[2], wv[3]); wf.z = pg8::cvt_pk_bf16(wv[4], wv[5]); wf.w = pg8::cvt_pk_bf16(wv[6], wv[7]);
        wfrag[ks] = __builtin_bit_cast(bf16x8, wf); }
    LDS_WAIT(); __syncthreads();
    f32x4 acc[2][8];
#pragma unroll
    for (int ch = 0; ch < 2; ++ch) { const LAS bf16* vnT = (const LAS bf16*)(lds + ch * 36864);
#pragma unroll
        for (int nb = 0; nb < 8; ++nb) acc[ch][nb] = (f32x4){0.f, 0.f, 0.f, 0.f};
#pragma unroll
        for (int ks = 0; ks < 4; ++ks) if (ks < nks) { const int s0 = 32 * ks + 8 * fq;
#pragma unroll
            for (int nb = 0; nb < 8; ++nb) { const bf16x8 vf = *(const LAS bf16x8*)(vnT + (16 * nb + fr) * VP + s0);
                acc[ch][nb] = __builtin_amdgcn_mfma_f32_16x16x32_bf16(vf, wfrag[ks], acc[ch][nb], 0, 0, 0); } } }
    mid();
#pragma unroll
    for (int ch = 0; ch < 2; ++ch) {
        const int t = t0 + fr; const size_t row = (size_t)(2 * cp + ch) * 128 + t;
#pragma unroll
        for (int nb = 0; nb < 8; ++nb) { const int c = 16 * nb + 4 * fq; const unsigned long long gw8 = gu8[ch][nb];
            const unsigned lo = (unsigned)gw8, hi = (unsigned)(gw8 >> 32);
            const float g0 = __uint_as_float(lo << 16), g1 = __uint_as_float(lo & 0xffff0000u), g2 = __uint_as_float(hi << 16), g3 = __uint_as_float(hi & 0xffff0000u);
            const unsigned long long o = (unsigned long long)pg8::cvt_pk_bf16(g0 * (acc[ch][nb][0] + bt), g1 * (acc[ch][nb][1] + bt)) | ((unsigned long long)pg8::cvt_pk_bf16(g2 * (acc[ch][nb][2] + bt), g3 * (acc[ch][nb][3] + bt)) << 32);
            *(GAS unsigned long long*)(AG + row * 1024 + 512 + g * 128 + c) = o; } }
    LDS_WAIT(); __syncthreads();
}
__device__ __forceinline__ void mix2_phase(KArgs ap, const Frame& F, int l_in, const XcdBarrier& bar) {
#define a (*ap)
    int l = l_in; asm volatile("" : "+s"(l));
    unsigned char* ws = WSP(a);
    const bf16* gu = (const bf16*)(ws + WS_R1 + R1_Q + 3 * R1_T); const bf16* gv = (const bf16*)(ws + WS_R1 + R1_Q + 4 * R1_T);
    const bf16* O12 = (const bf16*)(ws + WS_R1 + R1_O12); bf16* AG = (bf16*)(ws + WS_R1 + R1_AG);
    const int gw = F.vcu * NWAVES + F.wave, NGW = F.G * NWAVES;
    v4u w1[8], w2[8];
    auto mid = [&]() { xcd_wait(bar);
#pragma unroll
        for (int q = 0; q < 8; ++q) { const int m = gw + q * NGW, mm = m < M ? m : gw; w1[q] = *(const GAS v4u*)(O12 + (size_t)mm * 1024 + F.lane * 8); w2[q] = *(const GAS v4u*)(O12 + (size_t)mm * 1024 + 512 + F.lane * 8); } };
    gmlp_pair(F.vcu >> 2, F.vcu & 3, gu, gv, INP(a, 15) + (size_t)l * 4 * 128 * 128, INP(a, 16) + l * 512, INP(a, 13) + l * 512, INP(a, 14) + l * 512, AG, F.lds + RING_OFF, F.wave, F.lane, mid);
    const float li = (l == 0) ? 0.2f : 0.35550906759096934f;
    const float s1 = wave_sum(INP(a, 8)[l * 64 + F.lane] * INP(a, 9)[l * 64 + F.lane]), s2 = wave_sum(INP(a, 10)[l * 64 + F.lane] * INP(a, 11)[l * 64 + F.lane]);
    const float lam = __expf(s1) - __expf(s2) + li;
    const float* sub = INP(a, 12) + l * 128 + (F.lane & 15) * 8; float sg[8];
#pragma unroll
    for (int e = 0; e < 8; ++e) sg[e] = sub[e] * (1.0f - li);
    static_assert(M == 8 * 256 * NWAVES, "the combine is one trip of eight rows per wave");
    { const int m0 = gw;
#pragma unroll
        for (int q = 0; q < 8; ++q) { const int m = m0 + q * NGW; float d[8]; float ss = 0.f;
#pragma unroll
            for (int e = 0; e < 4; ++e) { const float a0 = __uint_as_float(w1[q][e] << 16), a1 = __uint_as_float(w1[q][e] & 0xffff0000u), b0 = __uint_as_float(w2[q][e] << 16), b1 = __uint_as_float(w2[q][e] & 0xffff0000u);
                d[2 * e] = a0 - lam * b0; d[2 * e + 1] = a1 - lam * b1; ss += d[2 * e] * d[2 * e] + d[2 * e + 1] * d[2 * e + 1]; }
            ss += __shfl_xor(ss, 1); ss += __shfl_xor(ss, 2); ss += __shfl_xor(ss, 4); ss += __shfl_xor(ss, 8);
            const float r = 1.0f / sqrtf(ss * (1.0f / 128.0f) + 1e-6f);
            v4u o; o.x = pg8::cvt_pk_bf16(d[0] * r * sg[0], d[1] * r * sg[1]); o.y = pg8::cvt_pk_bf16(d[2] * r * sg[2], d[3] * r * sg[3]); o.z = pg8::cvt_pk_bf16(d[4] * r * sg[4], d[5] * r * sg[5]); o.w = pg8::cvt_pk_bf16(d[6] * r * sg[6], d[7] * r * sg[7]);
            if (m < M) *(GAS v4u*)(AG + (size_t)m * 1024 + F.lane * 8) = o; }
    }
}
#undef a
#undef a
#define KA() ({ KArgs p_ = (KArgs)__builtin_amdgcn_kernarg_segment_ptr(); asm volatile("" : "+s"(p_)); p_; })
__device__ __forceinline__ Frame make_frame(LAS unsigned char* l) {
    Frame F; F.lds = l; int t_ = threadIdx.x; asm volatile("" : "+v"(t_)); F.tid = t_; F.lane = F.tid & 63; int w_ = __builtin_amdgcn_readfirstlane(F.tid >> 6); asm volatile("" : "+s"(w_)); F.wave = w_;
    F.G = gridDim.x; { const int bx = blockIdx.x; F.vcu = (F.G % 8 == 0) ? (bx % 8) * (F.G / 8) + bx / 8 : bx; } return F;
}
__global__ void __launch_bounds__(NWAVES * 64, 2) hybrid_fwd(Args args_unused) {
    extern __shared__ __attribute__((aligned(16))) unsigned char lds[];
    LAS unsigned char* const L = (LAS unsigned char*)lds;
    for (int u = threadIdx.x; u < (LDS_BYTES - LDSCTL_OFF) / 4; u += NWAVES * 64) ((LAS unsigned*)(L + LDSCTL_OFF))[u] = 0u;
    __syncthreads();
    XcdBarrier bar = xcd_barrier_post((unsigned*)((gu32*)(WSP(*KA()) + WS_CTL) + CW_BAR), (volatile LAS unsigned*)(L + MISC_OFF) + 8);
#define GRID_BAR() xcd_barrier(bar)
#if REPMASK
    for (int rep = 0; rep < (((REPMASK >> 12) & 1) ? 2 : 1); ++rep)
#endif
    { { KArgs a = KA(); const Frame F = make_frame(L); p0_prologue(a, F); }
    GRID_BAR(); }

#pragma nounroll
    for (int l = 0; l < DEPTH; ++l) {
#pragma nounroll
        for (int s = 0; s < 10; ++s) {
#if REPMASK
            for (int rep = 0; rep < (((REPMASK >> s) & 1) ? 2 : 1); ++rep) {
#else
            { const int rep = 0;
#endif
            KArgs a = KA(); unsigned char* ws = WSP(*a); unsigned char* r1 = ws + WS_R1; const unsigned char* wl = ws + WS_W;
            int bid_ = (int)blockIdx.x, G_ = (int)gridDim.x; asm volatile("" : "+s"(bid_), "+s"(G_));
            const int bid = bid_, G = G_;
            if (s == 0 || s == 8) {
                pg8::Gemm g = pg8::make_gemm((const bf16*)(ws + WS_HB), (const bf16*)(wl + (s == 0 ? WO_GU1 : WO_GU2)), DMODEL); pg8::StaticOrder S; S.init(M, 2 * DFF, G, bid);
                pg8::EpiSwiGLU E{(bf16*)(r1 + R1_HMID), DFF, (const float*)(ws + WS_STATS)};
                pg8::gemm_phase<pg8::EpiSwiGLU, pg8::StaticOrder, true, true>(L + RING_OFF, g, S, E);
                if (s == 0) {
                    if (l == 0) {
                        pg8::Gemm gk = pg8::make_gemm((const bf16*)(ws + WS_MEMN), (const bf16*)(ws + WS_WKV), DMODEL); pg8::KvOrder SK{bid - 128, 0};
                        pg8::EpiKV EK{(bf16*)(ws + WS_KC), (size_t)((WS_VC - WS_KC) / 2)};
                        pg8::gemm_phase<pg8::EpiKV, pg8::KvOrder, true, true>(L + RING_OFF, gk, SK, EK);
                        if (bid >= 144) { const Frame F = make_frame(L); convert_items(a, F, 0, IT_D1, IT_GU2, (bid - 144) * NWAVES + F.wave, 112 * NWAVES); }
                    } else if (bid >= 192) { const Frame F = make_frame(L); convert_items(a, F, 1, IT_GU2, IT_END, (bid - 192) * NWAVES + F.wave, 64 * NWAVES); }
                } else if (l == 0) {
                    pg8::Gemm gk = pg8::make_gemm((const bf16*)(ws + WS_MEMN), (const bf16*)(ws + WS_WKV), DMODEL); pg8::KvOrder SK{bid - 128, 1};
                    pg8::EpiKV EK{(bf16*)(ws + WS_KC), (size_t)((WS_VC - WS_KC) / 2)};
                    pg8::gemm_phase<pg8::EpiKV, pg8::KvOrder, true, true>(L + RING_OFF, gk, SK, EK);
                    if (bid >= 144) { const Frame F = make_frame(L); const int w = (bid - 144) * NWAVES + F.wave, nw = 112 * NWAVES;
                        convert_items(a, F, 1, IT_GU1, IT_KV, w, nw); convert_items(a, F, 1, IT_D1, IT_GU2, w, nw); }
                }
                if ((s == 0 && l == 1)) {
#define FOLD_UNITS(LAYER) do { \
                    { pg8::Gemm gq; gq.A = (const bf16*)(ws + WS_KC) + (size_t)(LAYER) * 512 * 1024; gq.Bt = (const bf16*)(wl + WO_Q); gq.lda = 1024; gq.ldb = 1024; gq.K = 256; gq.ash = 2; gq.bsh = 2; \
                      gq.a_hi = 256 * 1024; gq.a_lo = 256; gq.a_pn = 0; gq.b_hi = 0; gq.b_lo = 256; gq.b_pn = 256 * 1024; pg8::PreOrder SQ{bid - 128}; \
                      pg8::EpiRowBf16 EQ{(bf16*)(ws + WS_X1) + (size_t)(LAYER) * 2 * 1024 * 1024, 1024, nullptr, C2_CROSS}; \
                      pg8::gemm_phase<pg8::EpiRowBf16, pg8::PreOrder, true, true>(L + RING_OFF, gq, SQ, EQ); } \
                    { pg8::Gemm gv; gv.A = (const bf16*)(wl + WO_O); gv.Bt = (const bf16*)(ws + WS_VC) + (size_t)(LAYER) * 512 * 1024; gv.lda = 1024; gv.ldb = 1024; gv.K = 256; gv.ash = 2; gv.bsh = 2; \
                      gv.a_hi = 0; gv.a_lo = 256 * 1024; gv.a_pn = 256; gv.b_hi = 256 * 1024; gv.b_lo = 0; gv.b_pn = 256; pg8::PreOrder SV{bid - 160}; \
                      pg8::EpiRowBf16 EV{(bf16*)(ws + WS_X2) + (size_t)(LAYER) * 2 * 1024 * 1024, 1024, nullptr, 1.0f}; \
                      pg8::gemm_phase<pg8::EpiRowBf16, pg8::PreOrder, true, true>(L + RING_OFF, gv, SV, EV); } } while (0)
                    FOLD_UNITS(1);
                }
            } else if (s == 9 && l == DEPTH - 1) {
                pg8::Gemm g = pg8::make_gemm((const bf16*)(r1 + R1_HMID), (const bf16*)(wl + WO_D2), DFF); pg8::StaticOrder S; S.init(M, DMODEL, G, bid);
                pg8::EpiResidFinal E{(const bf16*)(ws + WS_HB), (float*)(ws + WS_STATS), INP(*a, 26), OUTP(*a), (unsigned*)(ws + WS_CTL) + CW_PANEL, 0.5f};
                pg8::gemm_phase<pg8::EpiResidFinal, pg8::StaticOrder, false, true>(L + RING_OFF, g, S, E);
            } else if (s == 1 || s == 9) {
                pg8::Gemm g = pg8::make_gemm((const bf16*)(r1 + R1_HMID), (const bf16*)(wl + (s == 1 ? WO_D1 : WO_D2)), DFF); pg8::StaticOrder S; S.init(M, DMODEL, G, bid);
                pg8::EpiResid E{(const float*)nullptr, (bf16*)(ws + WS_HB), (bf16*)(ws + WS_LO), (float*)(ws + WS_STATS), rep ? 0.0f : 0.5f};
                pg8::gemm_phase<pg8::EpiResid, pg8::StaticOrder, false, true>(L + RING_OFF, g, S, E);
            } else if (s == 5 || s == 7) {
                pg8::Gemm g = pg8::make_gemm((const bf16*)(r1 + (s == 5 ? R1_AG : R1_P)), s == 5 ? (const bf16*)(wl + WO_OUT) : (const bf16*)(ws + WS_X2) + (size_t)l * 2 * 1024 * 1024, DMODEL);
                g.bsh = 5; g.b_hi = (s == 5) ? 0 : 1024 * 1024;
                pg8::StaticOrder S; S.init(M, DMODEL, G, bid);
                pg8::EpiResid E{(const float*)nullptr, (bf16*)(ws + WS_HB), (bf16*)(ws + WS_LO), (float*)(ws + WS_STATS), rep ? 0.0f : 1.0f};
                pg8::gemm_phase<pg8::EpiResid, pg8::StaticOrder, false, true>(L + RING_OFF, g, S, E);
            } else if (s == 2) {
                pg8::Gemm g = pg8::make_gemm((const bf16*)(ws + WS_HB), (const bf16*)(wl + WO_IN), DMODEL); pg8::StaticOrder S; S.init(M, DIN, G, bid, 6);
                pg8::EpiWin E{(bf16*)(r1 + R1_Q), (size_t)(R1_T / 2), (const float*)(ws + WS_STATS), (const float*)(ws + WS_CS), C2_DIFF};
                pg8::gemm_phase<pg8::EpiWin, pg8::StaticOrder, true, true>(L + RING_OFF, g, S, E);
                if (l == 0) {
                    FOLD_UNITS(0);
                }
            } else if (s == 3) {
                const attn_body::AttnTensors AT{(const attn_body::bf16*)(r1 + R1_Q), (const attn_body::bf16*)(r1 + R1_Q + R1_T), (const attn_body::bf16*)(r1 + R1_Q + 2 * R1_T), (attn_body::bf16*)(r1 + R1_O12)};
                const attn_body::StaticOrder S(G, bid);
                attn_body::attn_phase<attn_body::StaticOrder>((char*)lds + RING_OFF, AT, S);
            } else if (s == 4) {
                const Frame F = make_frame(L); mix2_phase(a, F, l, bar);
            } else if (s == 6) {
                pg8::Gemm g = pg8::make_gemm((const bf16*)(ws + WS_HB), (const bf16*)(ws + WS_X1) + (size_t)l * 2 * 1024 * 1024, DMODEL); g.bsh = 5; g.b_hi = 1024 * 1024;
                pg8::StaticOrder S; S.init(M, DMODEL, G, bid);
                pg8::EpiScores E{(bf16*)(r1 + R1_P), (const float*)(ws + WS_STATS)};
                pg8::gemm_phase<pg8::EpiScores, pg8::StaticOrder, false, true>(L + RING_OFF, g, S, E);
            }
            if (s == 3) xcd_arrive(bar);
            else if (l == 0 && s <= 1) {
                xcd_arrive(bar);
                { const Frame F = make_frame(L); const int w = (F.vcu * NWAVES + F.wave) * 2 + s, nw = F.G * NWAVES * 2;
                  convert_items(a, F, 0, IT_GU2, IT_END, w, nw); convert_items(a, F, 1, IT_KV, IT_D1, w, nw); }
                xcd_wait(bar); }
            else if (!(s == 9 && l == DEPTH - 1)) GRID_BAR();
            }
        }
    }
#undef GRID_BAR
}

extern "C" void kernel_launch(void* const* d_in, const int* in_sizes, int n_in, void* d_out, int out_size, void* d_ws, size_t ws_size, hipStream_t stream) {
    static int grid = 0;
    if (grid == 0) {
        if (n_in != 27 || in_sizes[0] != M * DMODEL || out_size != M * DMODEL || ws_size < WS_END) { fprintf(stderr, "kernel_launch: unexpected shapes: n_in %d, in0 %d, out %d, ws %zu; nothing launched\n", n_in, n_in > 0 ? in_sizes[0] : -1, out_size, ws_size); grid = -1; return; }
        int dev = 0, cus = 0, per_cu = 0;
        if (hipGetDevice(&dev) != hipSuccess || hipDeviceGetAttribute(&cus, hipDeviceAttributeMultiprocessorCount, dev) != hipSuccess) { fprintf(stderr, "kernel_launch: device query failed\n"); grid = -1; return; }
        if (hipFuncSetAttribute((const void*)hybrid_fwd, hipFuncAttributeMaxDynamicSharedMemorySize, LDS_BYTES) != hipSuccess) { fprintf(stderr, "kernel_launch: hipFuncSetAttribute failed\n"); grid = -1; return; }
        if (hipOccupancyMaxActiveBlocksPerMultiprocessor(&per_cu, (const void*)hybrid_fwd, NWAVES * 64, LDS_BYTES) != hipSuccess || per_cu < 1) { fprintf(stderr, "kernel_launch: occupancy query reports %d workgroups per CU; nothing launched\n", per_cu); (void)hipGetLastError(); grid = -1; return; }
        if (cus < 256) { fprintf(stderr, "kernel_launch: %d CUs; this kernel needs 256 (one workgroup per CU); nothing launched\n", cus); grid = -1; return; }
        grid = 256;
    }
    if (grid < 0) return;
    if (hipMemsetAsync((char*)d_ws + WS_CTL, 0, CTL_ZERO_BYTES, stream) != hipSuccess) { fprintf(stderr, "kernel_launch: hipMemsetAsync failed\n"); return; }
    Args a{};
    for (int i = 0; i < 27; ++i) a.in[i] = (const float*)d_in[i];
    a.out = (float*)d_out; a.ws = (unsigned char*)d_ws;
    hipLaunchKernelGGL(hybrid_fwd, dim3(grid), dim3(NWAVES * 64), LDS_BYTES, stream, a);
    const hipError_t le = hipPeekAtLastError();
    if (le != hipSuccess) fprintf(stderr, "kernel_launch: launch failed: %s\n", hipGetErrorName(le));
}
```
